# Optimizing an MI355X kernel written in HIP

```python
import jax, jax.numpy as jnp
from jax import lax
import numpy as np

D_MODEL = 1024
BATCH = 2
SEQ = 16384
DEPTH = 1

GLA_HEADS = 4
GLA_DK = D_MODEL // 2
GLA_DV = D_MODEL
GLA_HEAD_K = GLA_DK // GLA_HEADS
GLA_HEAD_V = GLA_DV // GLA_HEADS
GLA_GATE_RANK = 16
GLA_GATE_TEMP = 16.0
GLA_CHUNK = 64
POOL_WIDTH = D_MODEL // 2
POOL_GROUPS = 4
POOL_GROUP_DIM = POOL_WIDTH // POOL_GROUPS
POOL_WINDOWS = (2, 4, 8, 16)
N_BRANCHES = 2
IN_SPLIT_SIZES = (GLA_DK, GLA_DK, GLA_DV, GLA_DV, GLA_GATE_RANK, POOL_WIDTH, D_MODEL, D_MODEL)
IN_COLS = sum(IN_SPLIT_SIZES)
N_EXPERTS = 64
TOP_K = 8
N_GROUPS = 8
TOP_GROUPS = 4
EXPERTS_PER_GROUP = N_EXPERTS // N_GROUPS
EXPERT_FF = 256
SHARED_FF = 256
ROUTE_SCALE = 2.5
MOE_BLOCK = 128
LN_EPS = 1e-5
RMS_EPS = 1e-6
DEEPNORM_ALPHA = (2.0 * DEPTH) ** 0.25
DEEPNORM_BETA = (8.0 * DEPTH) ** -0.25

kernel_name = "gla_pool_gated_moe_deepnorm_block"


def layer_norm(x, g, b):
    xf = x.astype(jnp.float32)
    mu = xf.mean(-1, keepdims=True)
    var = jnp.square(xf - mu).mean(-1, keepdims=True)
    y = (xf - mu) * lax.rsqrt(var + LN_EPS) * g.astype(jnp.float32) + b.astype(jnp.float32)
    return y.astype(x.dtype)


def rms_norm(x, g):
    xf = x.astype(jnp.float32)
    y = xf * lax.rsqrt(jnp.square(xf).mean(-1, keepdims=True) + RMS_EPS)
    return y * g.astype(jnp.float32)


def gla_chunked(q, k, v, log_g):
    B, S, H, dk = q.shape
    dv = v.shape[-1]
    n_chunks = S // GLA_CHUNK

    def to_chunks(t):
        return t.reshape(B, n_chunks, GLA_CHUNK, H, t.shape[-1]).transpose(1, 0, 3, 2, 4)

    causal = jnp.tril(jnp.ones((GLA_CHUNK, GLA_CHUNK), dtype=bool))[:, :, None]

    def step(state, inp):
        qi, ki, vi, gi = inp
        b = jnp.cumsum(gi, axis=-2)
        diff = b[..., :, None, :] - b[..., None, :, :]
        decay = jnp.exp(jnp.where(causal, diff, -jnp.inf))
        scores = jnp.einsum('bhid,bhjd,bhijd->bhij', qi, ki, decay)
        o_intra = jnp.einsum('bhij,bhjv->bhiv', scores, vi)
        o_inter = jnp.einsum('bhid,bhdv->bhiv', qi * jnp.exp(b), state)
        b_last = b[..., -1:, :]
        k_dec = ki * jnp.exp(b_last - b)
        new_state = (jnp.exp(b_last[..., 0, :])[..., None] * state
                     + jnp.einsum('bhjd,bhjv->bhdv', k_dec, vi))
        return new_state, o_intra + o_inter

    state0 = jnp.zeros((B, H, dk, dv), jnp.float32)
    _, o = lax.scan(step, state0, (to_chunks(q), to_chunks(k), to_chunks(v), to_chunks(log_g)))
    return o.transpose(1, 0, 3, 2, 4).reshape(B, S, H, dv)


def causal_window_mean(u, window):
    S = u.shape[1]
    cs = jnp.cumsum(u.astype(jnp.float32), axis=1)
    shifted = jnp.pad(cs, ((0, 0), (window, 0), (0, 0)))[:, :S]
    count = jnp.minimum(jnp.arange(1, S + 1), window).astype(jnp.float32)
    return (cs - shifted) / count[None, :, None]


def hybrid_mixer(x, w_in, w_gate_up, b_gate, gla_norm_g, w_gla_up,
                 w_pool_grp, pool_scale, w_pool_up, w_out):
    B, S, _ = x.shape
    proj = jnp.einsum('bsd,de->bse', x, w_in)
    split_points = [int(p) for p in np.cumsum(IN_SPLIT_SIZES)[:-1]]
    q, k, v, r, g_lr, u, gate_a, gate_b = jnp.split(proj, split_points, axis=-1)

    log_decay = jax.nn.log_sigmoid(
        jnp.einsum('bsr,rk->bsk', g_lr, w_gate_up).astype(jnp.float32)
        + b_gate.astype(jnp.float32)) / GLA_GATE_TEMP

    def heads(t, d):
        return t.reshape(B, S, GLA_HEADS, d).astype(jnp.float32)

    o = gla_chunked(heads(q, GLA_HEAD_K) * (GLA_HEAD_K ** -0.5), heads(k, GLA_HEAD_K),
                    heads(v, GLA_HEAD_V), log_decay.reshape(B, S, GLA_HEADS, GLA_HEAD_K))
    o = rms_norm(o, gla_norm_g).reshape(B, S, GLA_DV).astype(x.dtype)
    o = o * jax.nn.silu(r)
    y_gla = jnp.einsum('bsv,vd->bsd', o, w_gla_up)

    ug = u.reshape(B, S, POOL_GROUPS, POOL_GROUP_DIM)
    pooled = jnp.stack([causal_window_mean(ug[:, :, i], w) for i, w in enumerate(POOL_WINDOWS)],
                       axis=2) - ug.astype(jnp.float32)
    mixed = jnp.einsum('bsgc,gce->bsge', pooled.astype(x.dtype), w_pool_grp)
    mixed = mixed.reshape(B, S, POOL_WIDTH) * pool_scale
    y_pool = jnp.einsum('bsp,pd->bsd', mixed, w_pool_up)

    merged = jax.nn.sigmoid(gate_a) * y_gla + jax.nn.sigmoid(gate_b) * y_pool
    return jnp.einsum('bsd,de->bse', merged, w_out)


def moe_ffn(x, w_router, router_bias, w_exp_gate, w_exp_up, w_exp_down,
            w_sh_gate, w_sh_up, w_sh_down):
    B, S, D = x.shape
    x2 = x.reshape(B * S, D)
    T = x2.shape[0]
    scores = jax.nn.sigmoid(jnp.einsum('td,de->te', x2, w_router).astype(jnp.float32))
    biased = scores + router_bias.astype(jnp.float32)
    grp = biased.reshape(T, N_GROUPS, EXPERTS_PER_GROUP)
    grp_score = lax.top_k(grp, 2)[0].sum(-1)
    _, top_g = lax.top_k(grp_score, TOP_GROUPS)
    gmask = jax.nn.one_hot(top_g, N_GROUPS, dtype=jnp.float32).sum(-2) > 0
    emask = jnp.repeat(gmask, EXPERTS_PER_GROUP, axis=-1)
    _, top_e = lax.top_k(jnp.where(emask, biased, -jnp.inf), TOP_K)
    sel = jnp.take_along_axis(scores, top_e, axis=-1)
    weights = sel / sel.sum(-1, keepdims=True) * ROUTE_SCALE
    gates = (jax.nn.one_hot(top_e, N_EXPERTS, dtype=jnp.float32) * weights[..., None]).sum(-2)
    gates = gates.astype(x.dtype)

    def expert_block(args):
        xb, gb = args
        h = (jax.nn.silu(jnp.einsum('td,edf->tef', xb, w_exp_gate))
             * jnp.einsum('td,edf->tef', xb, w_exp_up))
        return jnp.einsum('tef,efd->td', h * gb[..., None], w_exp_down)

    n_blk = T // MOE_BLOCK
    routed = lax.map(expert_block, (x2.reshape(n_blk, MOE_BLOCK, D),
                                     gates.reshape(n_blk, MOE_BLOCK, N_EXPERTS)))
    routed = routed.reshape(T, D)
    shared = jnp.einsum('tf,fd->td', jax.nn.silu(x2 @ w_sh_gate) * (x2 @ w_sh_up), w_sh_down)
    return (routed + shared).reshape(B, S, D)


def setup_inputs(seed: int = 0) -> dict:
    key = jax.random.key(seed)
    ks = jax.random.split(key, 24)
    f32 = jnp.float32

    def nrm(k, shape, scale):
        return jax.random.normal(k, shape, f32) * scale

    L = DEPTH
    return {
        "x": nrm(ks[0], (BATCH, SEQ, D_MODEL), 1.0),
        "w_in": nrm(ks[1], (L, D_MODEL, IN_COLS), D_MODEL ** -0.5),
        "w_gate_up": nrm(ks[2], (L, GLA_GATE_RANK, GLA_DK), GLA_GATE_RANK ** -0.5),
        "b_gate": nrm(ks[3], (L, GLA_DK), 0.1),
        "gla_norm_g": 1.0 + nrm(ks[4], (L, GLA_HEAD_V), 0.02),
        "w_gla_up": nrm(ks[5], (L, GLA_DV, D_MODEL), GLA_DV ** -0.5),
        "w_pool_grp": nrm(ks[6], (L, POOL_GROUPS, POOL_GROUP_DIM, POOL_GROUP_DIM), POOL_GROUP_DIM ** -0.5),
        "pool_scale": 1.0 + nrm(ks[7], (L, POOL_WIDTH), 0.02),
        "w_pool_up": nrm(ks[8], (L, POOL_WIDTH, D_MODEL), POOL_WIDTH ** -0.5),
        "w_out": nrm(ks[9], (L, D_MODEL, D_MODEL), D_MODEL ** -0.5) * DEEPNORM_BETA,
        "ln1_g": 1.0 + nrm(ks[10], (L, D_MODEL), 0.02),
        "ln1_b": nrm(ks[11], (L, D_MODEL), 0.02),
        "w_router": nrm(ks[12], (L, D_MODEL, N_EXPERTS), D_MODEL ** -0.5),
        "router_bias": nrm(ks[13], (L, N_EXPERTS), 0.01),
        "w_exp_gate": nrm(ks[14], (L, N_EXPERTS, D_MODEL, EXPERT_FF), D_MODEL ** -0.5),
        "w_exp_up": nrm(ks[15], (L, N_EXPERTS, D_MODEL, EXPERT_FF), D_MODEL ** -0.5),
        "w_exp_down": nrm(ks[16], (L, N_EXPERTS, EXPERT_FF, D_MODEL), EXPERT_FF ** -0.5) * DEEPNORM_BETA,
        "w_sh_gate": nrm(ks[17], (L, D_MODEL, SHARED_FF), D_MODEL ** -0.5),
        "w_sh_up": nrm(ks[18], (L, D_MODEL, SHARED_FF), D_MODEL ** -0.5),
        "w_sh_down": nrm(ks[19], (L, SHARED_FF, D_MODEL), SHARED_FF ** -0.5) * DEEPNORM_BETA,
        "ln2_g": 1.0 + nrm(ks[20], (L, D_MODEL), 0.02),
        "ln2_b": nrm(ks[21], (L, D_MODEL), 0.02),
    }


def reference(x, w_in, w_gate_up, b_gate, gla_norm_g, w_gla_up, w_pool_grp, pool_scale,
              w_pool_up, w_out, ln1_g, ln1_b, w_router, router_bias, w_exp_gate, w_exp_up,
              w_exp_down, w_sh_gate, w_sh_up, w_sh_down, ln2_g, ln2_b):
    h = x
    for layer in range(DEPTH):
        mix = hybrid_mixer(h, w_in[layer], w_gate_up[layer], b_gate[layer], gla_norm_g[layer],
                           w_gla_up[layer], w_pool_grp[layer], pool_scale[layer],
                           w_pool_up[layer], w_out[layer])
        h = layer_norm(DEEPNORM_ALPHA * h + mix, ln1_g[layer], ln1_b[layer])
        ffn = moe_ffn(h, w_router[layer], router_bias[layer], w_exp_gate[layer], w_exp_up[layer],
                      w_exp_down[layer], w_sh_gate[layer], w_sh_up[layer], w_sh_down[layer])
        h = layer_norm(DEEPNORM_ALPHA * h + ffn, ln2_g[layer], ln2_b[layer])
    return h
```

```cpp
#include <hip/hip_runtime.h>
#include <cstdio>
#include <cstdint>
#include <cmath>
#define MK_FUSED 1
namespace pg8 {
#define PG8_LAS __attribute__((address_space(3)))
typedef unsigned short bf16_t;
typedef short bf16x8 __attribute__((ext_vector_type(8)));
typedef float f32x4 __attribute__((ext_vector_type(4)));
typedef float f32x2 __attribute__((ext_vector_type(2)));
typedef unsigned u32x4 __attribute__((ext_vector_type(4)));
typedef unsigned u32x2 __attribute__((ext_vector_type(2)));
typedef int i32x4 __attribute__((ext_vector_type(4)));
typedef int i32x8 __attribute__((ext_vector_type(8)));
constexpr int BM = 256, BK = 64, HALF = 128, HTB = HALF * BK * 2  , STAGE_BYTES = 8 * HTB, NXCD = 8, WGM = 4;

__host__ __device__ __forceinline__ int lds_byte(int r, int c) { const int st = (r >> 4) * 2 + (c >> 5), rr = r & 15, cc = c & 31, ob = rr * 64 + cc * 2; return st * 1024 + (ob ^ (((ob >> 9) & 1) << 5)); }
__host__ __device__ __forceinline__ void stage_rc(int b, int& R, int& C) { const int st = b / 1024, sb = b % 1024, swz = sb ^ (((sb >> 9) & 1) << 5); R = (st >> 1) * 16 + swz / 64; C = (st & 1) * 32 + (swz % 64) / 2; }
__host__ __device__ __forceinline__ int perm32(int rho) { const int n = rho >> 4, i = rho & 15; return 8 * (i >> 2) + 4 * n + (i & 3); }

struct Unit { int pm, pn, at, bt; };

__host__ __device__ __forceinline__ int xcd_remap(int wgid, int nwg) { const int q = nwg / NXCD, r = nwg % NXCD, xcd = wgid % NXCD, off = wgid / NXCD; return (xcd < r ? xcd * (q + 1) : r * (q + 1) + (xcd - r) * q) + off; }

struct StaticOrder {
    int nM, nN, nwg, G, c;
    __host__ __device__ void init(int M, int N, int G_, int c_) { nM = M / BM; nN = N / BM; nwg = nM * nN; G = G_; c = c_; }
    __host__ __device__ bool next(int i, Unit& u) const {
        const long L = (long)i * G + c; if (L >= nwg) return false;
        const int wgid = xcd_remap((int)L, nwg);
        const int nig = WGM * nN, gid = wgid / nig, fm = gid * WGM, gsz = (nM - fm) < WGM ? (nM - fm) : WGM;
        u.pm = fm + ((wgid % nig) % gsz); u.pn = (wgid % nig) / gsz; u.at = u.pm; u.bt = u.pn; return true;
    }
};

__device__ __forceinline__ unsigned cvt_pk_bf16(float lo, float hi) { unsigned r; asm volatile("v_cvt_pk_bf16_f32 %0, %1, %2" : "=v"(r) : "v"(lo), "v"(hi)); return r; }
__device__ __forceinline__ float bflo(unsigned w) { return __uint_as_float(w << 16); }
__device__ __forceinline__ float bfhi(unsigned w) { return __uint_as_float(w & 0xffff0000u); }
__device__ __forceinline__ float sigm(float x) { return __builtin_amdgcn_rcpf(1.0f + __expf(-x)); }
__device__ __forceinline__ u32x4 pack8(const f32x4& v0, const f32x4& v1) { u32x4 w; w.x = cvt_pk_bf16(v0[0], v0[1]); w.y = cvt_pk_bf16(v0[2], v0[3]); w.z = cvt_pk_bf16(v1[0], v1[1]); w.w = cvt_pk_bf16(v1[2], v1[3]); return w; }
__device__ __forceinline__ void unpack8(const u32x4& w, f32x4& v0, f32x4& v1) { v0 = (f32x4){bflo(w.x), bfhi(w.x), bflo(w.y), bfhi(w.y)}; v1 = (f32x4){bflo(w.z), bfhi(w.z), bflo(w.w), bfhi(w.w)}; }

__device__ __forceinline__ void st16_wt(void* p, u32x4 v) { asm volatile("global_store_dwordx4 %0, %1, off sc1" :: "v"(p), "v"(v)); }
template <bool WT> __device__ __forceinline__ void st16(void* p, u32x4 v) { if constexpr (WT) __builtin_nontemporal_store(v, (u32x4*)p); else *(u32x4*)p = v; }
#ifndef WT_PROJ
#define WT_PROJ 0
#endif
#ifndef WT_GATE
#define WT_GATE 0
#endif
#ifndef WT_PRE1
#define WT_PRE1 0
#endif
#ifndef WT_PRE2
#define WT_PRE2 0
#endif
struct EpiBf16 {
    static constexpr bool PERM = true;
    bf16_t* O; int ldc;
    __device__ __forceinline__ void operator()(const f32x4 (&acc)[2][2][4][2], const Unit& u, int wr, int wc, int fr, int fq) const {
        const int row0 = u.pm * BM + wr * 64 + fr, col0 = u.pn * BM + wc * 32 + 8 * fq;
#pragma unroll
        for (int ai = 0; ai < 2; ++ai)
#pragma unroll
            for (int m = 0; m < 4; ++m) { bf16_t* rowp = O + (size_t)(row0 + ai * HALF + m * 16) * ldc + col0;
#pragma unroll
                for (int bj = 0; bj < 2; ++bj) st16<false>(rowp + bj * HALF, pack8(acc[ai][bj][m][0], acc[ai][bj][m][1])); }
    }
};
__device__ __forceinline__ unsigned pk4_fp8(float a, float b, float c, float d) {
    int p = 0; p = __builtin_amdgcn_cvt_pk_fp8_f32(__builtin_amdgcn_fmed3f(a, -440.f, 440.f), __builtin_amdgcn_fmed3f(b, -440.f, 440.f), p, false);
    p = __builtin_amdgcn_cvt_pk_fp8_f32(__builtin_amdgcn_fmed3f(c, -440.f, 440.f), __builtin_amdgcn_fmed3f(d, -440.f, 440.f), p, true); return (unsigned)p; }
struct EpiMoe1F8 {
    static constexpr bool PERM = true;
    unsigned char* H; const float* RW;
    __device__ __forceinline__ void operator()(const f32x4 (&acc)[2][2][4][2], const Unit& u, int wr, int wc, int fr, int fq) const {
        const int row0 = u.pm * BM + wr * 64 + fr, col0 = u.pn * HALF + wc * 32 + 8 * fq;
#pragma unroll
        for (int ai = 0; ai < 2; ++ai)
#pragma unroll
            for (int m = 0; m < 4; ++m) { const int row = row0 + ai * HALF + m * 16; const float w = RW[row] * 16.0f;
                float v[8];
#pragma unroll
                for (int j = 0; j < 4; ++j) { const float g0 = acc[ai][0][m][0][j], g1 = acc[ai][0][m][1][j];
                    v[j] = g0 * sigm(g0) * acc[ai][1][m][0][j] * w; v[4 + j] = g1 * sigm(g1) * acc[ai][1][m][1][j] * w; }
                *(u32x2*)(H + (size_t)row * 256 + col0) = (u32x2){pk4_fp8(v[0], v[1], v[2], v[3]), pk4_fp8(v[4], v[5], v[6], v[7])}; }
    }
};
struct EpiFp8 {
    static constexpr int PERM = 2;
    unsigned char* O; int ldc; float scale;
    __device__ __forceinline__ void operator()(const f32x4 (&acc)[2][2][4][2], const Unit& u, int wr, int wc, int fr, int fq) const {
        const int row0 = u.pm * BM + wr * 64 + fr, col0 = u.pn * BM + wc * 64 + 16 * fq;
#pragma unroll
        for (int ai = 0; ai < 2; ++ai)
#pragma unroll
            for (int m = 0; m < 4; ++m) { unsigned char* rowp = O + (size_t)(row0 + ai * HALF + m * 16) * ldc + col0; u32x4 w;
#pragma unroll
                for (int bj = 0; bj < 2; ++bj)
#pragma unroll
                    for (int n = 0; n < 2; ++n) { const f32x4 v = (scale == 1.0f) ? acc[ai][bj][m][n] : acc[ai][bj][m][n] * scale; int p = 0;
                        p = __builtin_amdgcn_cvt_pk_fp8_f32(v[0], v[1], p, false); p = __builtin_amdgcn_cvt_pk_fp8_f32(v[2], v[3], p, true); w[bj * 2 + n] = (unsigned)p; }
                *(u32x4*)rowp = w; }
    }
};
struct EpiProj {
    static constexpr bool PERM = true;
    bf16_t *QK, *V, *R, *U, *GA, *GB;
    __device__ __forceinline__ void operator()(const f32x4 (&acc)[2][2][4][2], const Unit& u, int wr, int wc, int fr, int fq) const {
        const int pn = u.pn; bf16_t* base; int ldc = 1024, ct;
        if (pn < 4) { base = QK; ct = pn; } else if (pn < 8) { base = V; ct = pn - 4; } else if (pn < 12) { base = R; ct = pn - 8; }
        else if (pn < 14) { base = U; ct = pn - 12; ldc = 512; } else if (pn < 18) { base = GA; ct = pn - 14; } else { base = GB; ct = pn - 18; }
        const int row0 = u.pm * BM + wr * 64 + fr, col0 = ct * BM + wc * 32 + 8 * fq;
#pragma unroll
        for (int ai = 0; ai < 2; ++ai)
#pragma unroll
            for (int m = 0; m < 4; ++m) { bf16_t* rowp = base + (size_t)(row0 + ai * HALF + m * 16) * ldc + col0;
#pragma unroll
                for (int bj = 0; bj < 2; ++bj) st16<WT_PROJ != 0>(rowp + bj * HALF, pack8(acc[ai][bj][m][0], acc[ai][bj][m][1])); }
    }
};
template <int MODE> struct EpiGate {
    static constexpr bool PERM = true;
    const bf16_t* G; const bf16_t* P; bf16_t* O;
    __device__ __forceinline__ void operator()(const f32x4 (&acc)[2][2][4][2], const Unit& u, int wr, int wc, int fr, int fq) const {
        const int row0 = u.pm * BM + wr * 64 + fr, col0 = u.pn * BM + wc * 32 + 8 * fq;
#pragma unroll
        for (int ai = 0; ai < 2; ++ai)
#pragma unroll
            for (int m = 0; m < 4; ++m) { const size_t off = (size_t)(row0 + ai * HALF + m * 16) * 1024 + col0;
#pragma unroll
                for (int bj = 0; bj < 2; ++bj) {
                    const u32x4 gw = *(const u32x4*)(G + off + bj * HALF); f32x4 g0, g1; unpack8(gw, g0, g1);
                    f32x4 v0 = acc[ai][bj][m][0], v1 = acc[ai][bj][m][1];
#pragma unroll
                    for (int j = 0; j < 4; ++j) { v0[j] *= sigm(g0[j]); v1[j] *= sigm(g1[j]); }
                    if (MODE == 1) { const u32x4 pw = *(const u32x4*)(P + off + bj * HALF); f32x4 p0, p1; unpack8(pw, p0, p1); v0 += p0; v1 += p1; }
                    st16<WT_GATE != 0>(O + off + bj * HALF, pack8(v0, v1)); } }
    }
};
struct EpiPre1 {
    static constexpr bool PERM = true;
    const float* X; bf16_t* O; float alpha; float* PST;
    __device__ __forceinline__ void operator()(const f32x4 (&acc)[2][2][4][2], const Unit& u, int wr, int wc, int fr, int fq) const {
        const int row0 = u.pm * BM + wr * 64 + fr, col0 = u.pn * BM + wc * 32 + 8 * fq;
#pragma unroll
        for (int ai = 0; ai < 2; ++ai)
#pragma unroll
            for (int m = 0; m < 4; ++m) { const int row = row0 + ai * HALF + m * 16; float s = 0.f, q = 0.f;
#pragma unroll
                for (int bj = 0; bj < 2; ++bj) { const float* xp = X + (size_t)row * 1024 + col0 + bj * HALF;
                    const f32x4 p0 = *(const f32x4*)xp * alpha + acc[ai][bj][m][0], p1 = *(const f32x4*)(xp + 4) * alpha + acc[ai][bj][m][1];
                    st16<WT_PRE1 != 0>(O + (size_t)row * 2048 + col0 + bj * HALF, pack8(p0, p1));
                    s += ((p0[0] + p0[1]) + (p0[2] + p0[3])) + ((p1[0] + p1[1]) + (p1[2] + p1[3]));
                    q += ((p0[0] * p0[0] + p0[1] * p0[1]) + (p0[2] * p0[2] + p0[3] * p0[3])) + ((p1[0] * p1[0] + p1[1] * p1[1]) + (p1[2] * p1[2] + p1[3] * p1[3])); }
                { auto a = __builtin_amdgcn_permlane16_swap(__float_as_uint(s), __float_as_uint(s), false, false); s = __uint_as_float(a[0]) + __uint_as_float(a[1]);
                  auto b = __builtin_amdgcn_permlane32_swap(__float_as_uint(s), __float_as_uint(s), false, false); s = __uint_as_float(b[0]) + __uint_as_float(b[1]);
                  auto c = __builtin_amdgcn_permlane16_swap(__float_as_uint(q), __float_as_uint(q), false, false); q = __uint_as_float(c[0]) + __uint_as_float(c[1]);
                  auto d = __builtin_amdgcn_permlane32_swap(__float_as_uint(q), __float_as_uint(q), false, false); q = __uint_as_float(d[0]) + __uint_as_float(d[1]); }
                if (fq == 0) *(f32x2*)(PST + ((size_t)row * 16 + u.pn * 4 + wc) * 2) = (f32x2){s, q}; }
    }
};
struct EpiPre2 {
    static constexpr bool PERM = true;
    bf16_t* IO; const float* ST; const float* g; const float* b; float alpha; float ascale;
    __device__ __forceinline__ void operator()(f32x4 (&acc)[2][2][4][2], const Unit& u, int wr, int wc, int fr, int fq) const {
        const unsigned row0 = (unsigned)(u.pm * BM + wr * 64 + fr), col0 = (unsigned)(u.pn * BM + wc * 32 + 8 * fq);
        const unsigned char* STb = (const unsigned char*)ST; unsigned char* IOb = (unsigned char*)IO;
#pragma unroll
        for (int bj = 0; bj < 2; ++bj) { const f32x4 g0 = *(const f32x4*)(g + col0 + bj * HALF), g1 = *(const f32x4*)(g + col0 + bj * HALF + 4), b0 = *(const f32x4*)(b + col0 + bj * HALF), b1 = *(const f32x4*)(b + col0 + bj * HALF + 4);
#pragma unroll
            for (int ai = 0; ai < 2; ++ai)
#pragma unroll
                for (int m = 0; m < 4; ++m) { const unsigned row = row0 + (unsigned)(ai * HALF + m * 16); const f32x2 st = *(const f32x2*)(STb + row * 8u);
                    u32x4* pp = (u32x4*)(IOb + (row * 2048u + col0 + (unsigned)(bj * HALF)) * 2u); f32x4 p0, p1; unpack8(*pp, p0, p1);
                    const f32x4 r0 = acc[ai][bj][m][0] * ascale + ((p0 - st.x) * st.y * g0 + b0) * alpha, r1 = acc[ai][bj][m][1] * ascale + ((p1 - st.x) * st.y * g1 + b1) * alpha;
                    st16<WT_PRE2 != 0>(pp, pack8(r0, r1)); }
            asm volatile("" ::: "memory"); }
    }
};
struct EpiMoe1 {
    static constexpr bool PERM = true;
    bf16_t* H; const float* RW;
    __device__ __forceinline__ void operator()(const f32x4 (&acc)[2][2][4][2], const Unit& u, int wr, int wc, int fr, int fq) const {
        const int row0 = u.pm * BM + wr * 64 + fr, col0 = u.pn * HALF + wc * 32 + 8 * fq;
#pragma unroll
        for (int ai = 0; ai < 2; ++ai)
#pragma unroll
            for (int m = 0; m < 4; ++m) { const int row = row0 + ai * HALF + m * 16; const float w = RW[row];
                f32x4 v0, v1;
#pragma unroll
                for (int j = 0; j < 4; ++j) { const float g0 = acc[ai][0][m][0][j], g1 = acc[ai][0][m][1][j];
                    v0[j] = g0 * sigm(g0) * acc[ai][1][m][0][j] * w; v1[j] = g1 * sigm(g1) * acc[ai][1][m][1][j] * w; }
                *(u32x4*)(H + (size_t)row * 256 + col0) = pack8(v0, v1); }
    }
};

template <class Epi, class Sched, bool ALIGN_EPI, bool SP2, bool GATHER, bool FP8 = false, int F8SHIFT = 0>
__device__ __forceinline__ void gemm_phase(PG8_LAS unsigned char* lds, const bf16_t* Aop, const bf16_t* Bop, const int K_, const Sched& S, const Epi& E, const PG8_LAS int* idxtab) {
    int K = K_; asm volatile("" : "+s"(K));
    int tid_ = threadIdx.x; asm volatile("" : "+v"(tid_));
    const int tid = tid_, wid = __builtin_amdgcn_readfirstlane(tid >> 6), lane = tid & 63, wr = wid >> 2, wc = wid & 3, fr = lane & 15, fq = lane >> 4;
    const int nt = K / BK;
    unsigned voffA[2], voffB[2]; int RA[2], CA[2];
#pragma unroll
    for (int i = 0; i < 2; ++i) { int R, C; stage_rc(tid * 16 + i * 8192, R, C);
        const int Rb = (int)Epi::PERM == 2 ? (64 * (R >> 5) + 16 * ((R >> 2) & 3) + 4 * ((R >> 4) & 1) + (R & 3)) : (int)Epi::PERM == 1 ? ((R & ~31) + perm32(R & 31)) : R;
        voffA[i] = (unsigned)(R * K + C) * 2u; voffB[i] = (unsigned)(Rb * K + C) * 2u; RA[i] = R; CA[i] = C; }
    const size_t kstep = (size_t)(BK * 2);
    const size_t hstep = (size_t)HALF * K * 2;
    const size_t tstep = 2 * hstep;
    const size_t bh1 = (int)Epi::PERM == 2 ? (size_t)16 * K : hstep;
    const unsigned ldsw = (unsigned)wid * 1024u;
    const int aoff = lds_byte(wr * 64 + fr, fq * 8), boff = lds_byte(wc * 32 + fr, fq * 8);
    unsigned vAc[2][2], vAn[2][2];
#define PG8_GIDX(dst, ord) do { _Pragma("unroll") for (int _h = 0; _h < 2; ++_h) _Pragma("unroll") for (int _i = 0; _i < 2; ++_i) \
        dst[_h][_i] = (unsigned)(idxtab[(ord) * 256 + _h * HALF + RA[_i]] * K + CA[_i]) * 2u; } while (0)
#define PG8_SA(b, h) (((b) * 2 + (h)) * HTB)
#define PG8_SB(b, h) ((4 + (b) * 2 + (h)) * HTB)
#define PG8_STAGE(bufoff, gbase, voff) do { _Pragma("unroll") for (int _i = 0; _i < 2; ++_i) \
        __builtin_amdgcn_global_load_lds((const unsigned*)((const char*)(gbase) + (voff)[_i]), (PG8_LAS unsigned*)(lds + (bufoff) + ldsw + _i * 8192), 16, 0, 0); } while (0)
#define PG8_STAGE_A(bufoff, kptr, h, nx) do { if constexpr (GATHER) { unsigned _v[2]; _v[0] = (nx) ? vAn[h][0] : vAc[h][0]; _v[1] = (nx) ? vAn[h][1] : vAc[h][1]; PG8_STAGE(bufoff, kptr, _v); } \
        else { PG8_STAGE(bufoff, (kptr) + (h) * hstep, voffA); } } while (0)
#define PG8_LD8(dst, off) do { const i32x4 lo_ = *(const PG8_LAS i32x4*)(lds + (off)), hi_ = *(const PG8_LAS i32x4*)(lds + (off) + 1024); dst = __builtin_shufflevector(lo_, hi_, 0, 1, 2, 3, 4, 5, 6, 7); } while (0)
#define PG8_LDA(dst, b, h) do { if constexpr (FP8) { _Pragma("unroll") for (int m = 0; m < 4; ++m) PG8_LD8(dst##8[m], PG8_SA(b, h) + aoff + m * 2048); } \
        else { _Pragma("unroll") for (int m = 0; m < 4; ++m) _Pragma("unroll") for (int k = 0; k < 2; ++k) dst[m][k] = *(const PG8_LAS bf16x8*)(lds + PG8_SA(b, h) + aoff + m * 2048 + k * 1024); } } while (0)
#define PG8_LDB(dst, b, h) do { if constexpr (FP8) { _Pragma("unroll") for (int n = 0; n < 2; ++n) PG8_LD8(dst##8[n], PG8_SB(b, h) + boff + n * 2048); } \
        else { _Pragma("unroll") for (int n = 0; n < 2; ++n) _Pragma("unroll") for (int k = 0; k < 2; ++k) dst[n][k] = *(const PG8_LAS bf16x8*)(lds + PG8_SB(b, h) + boff + n * 2048 + k * 1024); } } while (0)
#define PG8_MMA(ai, bj, At, Bt) do { __builtin_amdgcn_s_setprio(1); \
        if constexpr (FP8) { if (zc) { _Pragma("unroll") for (int m = 0; m < 4; ++m) _Pragma("unroll") for (int n = 0; n < 2; ++n) \
                asm volatile("v_mfma_scale_f32_16x16x128_f8f6f4 %0, %1, %2, 0, %3, %4 op_sel_hi:[0,0,0]" : "=&v"(acc[ai][bj][m][n]) : "v"(Bt##8[n]), "v"(At##8[m]), "v"(f8sa), "v"(f8sb)); } \
            else { _Pragma("unroll") for (int m = 0; m < 4; ++m) _Pragma("unroll") for (int n = 0; n < 2; ++n) \
                asm volatile("v_mfma_scale_f32_16x16x128_f8f6f4 %0, %1, %2, %0, %3, %4 op_sel_hi:[0,0,0]" : "+v"(acc[ai][bj][m][n]) : "v"(Bt##8[n]), "v"(At##8[m]), "v"(f8sa), "v"(f8sb)); } } \
        else { _Pragma("unroll") for (int m = 0; m < 4; ++m) _Pragma("unroll") for (int n = 0; n < 2; ++n) _Pragma("unroll") for (int k = 0; k < 2; ++k) \
            acc[ai][bj][m][n] = __builtin_amdgcn_mfma_f32_16x16x32_bf16(Bt[n][k], At[m][k], acc[ai][bj][m][n], 0, 0, 0); } \
        __builtin_amdgcn_s_setprio(0); } while (0)
#define PG8_WAIT_V(n) asm volatile("s_waitcnt vmcnt(" #n ")" ::: "memory")
#define PG8_WAIT_L(n) asm volatile("s_waitcnt lgkmcnt(" #n ")" ::: "memory")
#define PG8_BAR __builtin_amdgcn_s_barrier()
#define PG8_SCHED __builtin_amdgcn_sched_barrier(0)
    Unit cur, nxt; int ui = 0;
    if (!S.next(0, cur)) return;
    f32x4 acc[2][2][4][2];
    if constexpr (!FP8)
#pragma unroll
    for (int a = 0; a < 2; ++a)
#pragma unroll
        for (int b = 0; b < 2; ++b)
#pragma unroll
            for (int m = 0; m < 4; ++m)
#pragma unroll
                for (int n = 0; n < 2; ++n) acc[a][b][m][n] = (f32x4){0.f, 0.f, 0.f, 0.f};
    bf16x8 At[4][2], B0[2][2], B1[2][2]; i32x8 At8[4], B08[2], B18[2];
    (void)At; (void)B0; (void)B1; (void)At8; (void)B08; (void)B18;
    int f8sa = 0x01010101 * (127 + F8SHIFT), f8sb = 0x7f7f7f7f; asm volatile("" : "+v"(f8sa), "+v"(f8sb)); (void)f8sa; (void)f8sb;
    const char* cA = (const char*)Aop + (GATHER ? (size_t)0 : (size_t)cur.at * tstep); const char* cB = (const char*)Bop + (size_t)cur.bt * tstep;
    if constexpr (GATHER) { PG8_GIDX(vAc, 0); }
    if constexpr (SP2) {
        PG8_STAGE(PG8_SB(0, 0), cB, voffB); PG8_STAGE(PG8_SB(0, 1), cB + bh1, voffB); PG8_STAGE_A(PG8_SA(0, 0), cA, 0, false); PG8_STAGE_A(PG8_SA(0, 1), cA, 1, false);
        if (wr == 1) PG8_BAR;
        PG8_WAIT_V(2); PG8_BAR;
        PG8_STAGE(PG8_SB(1, 0), cB + kstep, voffB); PG8_STAGE_A(PG8_SA(1, 0), cA + kstep, 0, false); PG8_STAGE(PG8_SB(1, 1), cB + bh1 + kstep, voffB);
        PG8_WAIT_V(6); PG8_BAR;
    } else {
        PG8_STAGE(PG8_SB(0, 0), cB, voffB); PG8_STAGE_A(PG8_SA(0, 0), cA, 0, false); PG8_STAGE(PG8_SB(0, 1), cB + bh1, voffB); PG8_STAGE_A(PG8_SA(0, 1), cA, 1, false);
        if (wr == 1) PG8_BAR;
        PG8_WAIT_V(4); PG8_BAR;
        PG8_STAGE(PG8_SB(1, 0), cB + kstep, voffB); PG8_STAGE_A(PG8_SA(1, 0), cA + kstep, 0, false); PG8_STAGE(PG8_SB(1, 1), cB + bh1 + kstep, voffB);
        PG8_WAIT_V(6); PG8_BAR;
    }
    for (;;) {
        const bool has_next = S.next(ui + 1, nxt);
        const char* nA = (has_next && !GATHER) ? (const char*)Aop + (size_t)nxt.at * tstep : cA; const char* nB = has_next ? (const char*)Bop + (size_t)nxt.bt * tstep : cB;
        if constexpr (GATHER) { if (has_next) { PG8_GIDX(vAn, ui + 1); } else {
#pragma unroll
            for (int _h = 0; _h < 2; ++_h) { vAn[_h][0] = vAc[_h][0]; vAn[_h][1] = vAc[_h][1]; } } }
#pragma nounroll
        for (int t = 0; t < nt; t += 2) {
            const bool last = (t == nt - 2);
            const char* a1 = cA + (size_t)(t + 1) * kstep;
            const char* a2 = last ? nA : cA + (size_t)(t + 2) * kstep; const char* b2 = last ? nB : cB + (size_t)(t + 2) * kstep;
            const char* a3 = a2 + kstep; const char* b3 = b2 + kstep;
            if constexpr (SP2) {
            bool zc = FP8 && (t == 0); (void)zc;
            PG8_LDB(B0, 0, 0); PG8_LDB(B1, 0, 1); PG8_SCHED; PG8_LDA(At, 0, 0); PG8_STAGE_A(PG8_SA(1, 1), a1, 1, false);
            PG8_WAIT_V(8); PG8_WAIT_L(0); PG8_BAR; PG8_MMA(0, 0, At, B0); PG8_MMA(0, 1, At, B1); PG8_BAR; PG8_SCHED;
            PG8_LDA(At, 0, 1); PG8_STAGE(PG8_SB(0, 0), b2, voffB); PG8_STAGE(PG8_SB(0, 1), b2 + bh1, voffB); PG8_STAGE_A(PG8_SA(0, 0), a2, 0, last);
            PG8_WAIT_V(8); PG8_WAIT_L(0); PG8_BAR; PG8_MMA(1, 0, At, B0); PG8_MMA(1, 1, At, B1); PG8_BAR; PG8_SCHED;
            zc = false;
            PG8_LDB(B0, 1, 0); PG8_LDB(B1, 1, 1); PG8_SCHED; PG8_LDA(At, 1, 0); PG8_STAGE_A(PG8_SA(0, 1), a2, 1, last);
            PG8_WAIT_V(8); PG8_WAIT_L(0); PG8_BAR; PG8_MMA(0, 0, At, B0); PG8_MMA(0, 1, At, B1); PG8_BAR; PG8_SCHED;
            PG8_LDA(At, 1, 1); PG8_STAGE(PG8_SB(1, 0), b3, voffB); PG8_STAGE(PG8_SB(1, 1), b3 + bh1, voffB); PG8_STAGE_A(PG8_SA(1, 0), a3, 0, last);
            PG8_WAIT_V(8); PG8_WAIT_L(0); PG8_BAR; PG8_MMA(1, 0, At, B0); PG8_MMA(1, 1, At, B1); PG8_BAR; PG8_SCHED;
            } else {
            bool zc = FP8 && (t == 0); (void)zc;
            PG8_LDB(B0, 0, 0); PG8_SCHED; PG8_LDA(At, 0, 0); PG8_STAGE_A(PG8_SA(1, 1), a1, 1, false);
            PG8_WAIT_L(8); PG8_BAR; PG8_WAIT_L(0); PG8_MMA(0, 0, At, B0); PG8_BAR; PG8_SCHED;
            PG8_LDB(B1, 0, 1); PG8_STAGE(PG8_SB(0, 0), b2, voffB);
            PG8_BAR; PG8_WAIT_L(0); PG8_MMA(0, 1, At, B1); PG8_BAR;
            PG8_LDA(At, 0, 1); PG8_STAGE_A(PG8_SA(0, 0), a2, 0, last);
            PG8_BAR; PG8_WAIT_L(0); PG8_MMA(1, 0, At, B0); PG8_BAR; PG8_SCHED;
            PG8_STAGE(PG8_SB(0, 1), b2 + bh1, voffB);
            PG8_WAIT_V(6); PG8_BAR; PG8_MMA(1, 1, At, B1); PG8_BAR;
            zc = false;
            PG8_LDB(B0, 1, 0); PG8_SCHED; PG8_LDA(At, 1, 0); PG8_STAGE_A(PG8_SA(0, 1), a2, 1, last);
            PG8_WAIT_L(8); PG8_BAR; PG8_WAIT_L(0); PG8_MMA(0, 0, At, B0); PG8_BAR; PG8_SCHED;
            PG8_LDB(B1, 1, 1); PG8_STAGE(PG8_SB(1, 0), b3, voffB);
            PG8_BAR; PG8_WAIT_L(0); PG8_MMA(0, 1, At, B1); PG8_BAR;
            PG8_LDA(At, 1, 1); PG8_STAGE_A(PG8_SA(1, 0), a3, 0, last);
            PG8_BAR; PG8_WAIT_L(0); PG8_MMA(1, 0, At, B0); PG8_BAR; PG8_SCHED;
            PG8_STAGE(PG8_SB(1, 1), b3 + bh1, voffB);
            PG8_WAIT_V(6); PG8_BAR; PG8_MMA(1, 1, At, B1); PG8_BAR;
            }
        }
        if constexpr (FP8) asm volatile("s_nop 15\n\ts_nop 15" ::: "memory");
        if constexpr (ALIGN_EPI) { if (wr == 0) PG8_BAR; }
        E(acc, cur, wr, wc, fr, fq);
        if (!has_next) break;
        if constexpr (!FP8)
#pragma unroll
        for (int a = 0; a < 2; ++a)
#pragma unroll
            for (int b = 0; b < 2; ++b)
#pragma unroll
                for (int m = 0; m < 4; ++m)
#pragma unroll
                    for (int n = 0; n < 2; ++n) acc[a][b][m][n] = (f32x4){0.f, 0.f, 0.f, 0.f};
        cur = nxt; cA = nA; cB = nB; ++ui;
        if constexpr (GATHER) {
#pragma unroll
            for (int _h = 0; _h < 2; ++_h) { vAc[_h][0] = vAn[_h][0]; vAc[_h][1] = vAn[_h][1]; } }
        if constexpr (ALIGN_EPI) { if (wr == 1) PG8_BAR; }
    }
    PG8_WAIT_V(0);
    if constexpr (!ALIGN_EPI) { if (wr == 0) PG8_BAR; }
    PG8_BAR;
#undef PG8_GIDX
#undef PG8_SA
#undef PG8_SB
#undef PG8_STAGE
#undef PG8_STAGE_A
#undef PG8_LDA
#undef PG8_LDB
#undef PG8_MMA
#undef PG8_LD8
#undef PG8_WAIT_V
#undef PG8_WAIT_L
#undef PG8_BAR
#undef PG8_SCHED
}
}
#ifndef PG8_SP2
#define PG8_SP2 true
#endif
#ifndef PG8_ALIGN
#define PG8_ALIGN true
#endif
#ifndef MK_FUSED
#define MK_FUSED 1
#endif

constexpr int NWAVES = 8;
constexpr int BATCH = 2, SEQ = 16384, D = 1024, T = BATCH * SEQ;
constexpr int IN_COLS = 5648, NPROJ = 5632;
constexpr int GH = 4, GDK = 128, GDV = 256, GRANK = 16;
constexpr int PW = 512;
constexpr int NE = 64, TOPK = 8, NGRP = 8, FF = 256;
constexpr float LN_EPS = 1e-5f, RMS_EPS = 1e-6f;
constexpr float DN_ALPHA = 1.189207115002721f;
constexpr float ROUTE_SCALE = 2.5f;
constexpr int ROUTED_TILES = 1088, SH_TILES = T / 256;
constexpr float Y_SCALE = 16.0f;
constexpr float W_SCALE = 32.0f, H_SCALE = 16.0f;
constexpr int ALL_ROWS = (ROUTED_TILES + SH_TILES) * 256;

constexpr size_t MiB = 1u << 20;
constexpr size_t WS_CTL = 0, CTL_ZERO_BYTES = 1 * MiB;
constexpr size_t WS_TAB = 1 * MiB;
constexpr size_t TAB_CNT = WS_TAB, TAB_TILEE = WS_TAB + 65536, TAB_META = WS_TAB + 73728, TAB_STATS = WS_TAB + 262144;
constexpr size_t WS_WIN = 2 * MiB, WS_WGLA = 13 * MiB, WS_WPC = 15 * MiB, WS_WOUT = 16 * MiB;
constexpr size_t WS_GLR = 18 * MiB;
constexpr size_t WS_L = 20 * MiB;
constexpr size_t WS_XB = 52 * MiB;
constexpr size_t WS_PO = 52 * MiB, WS_OG = 84 * MiB;
constexpr size_t WS_QK = 148 * MiB, WS_V = 212 * MiB, WS_R = 276 * MiB, WS_U = 340 * MiB, WS_GA = 372 * MiB, WS_GB = 436 * MiB;
constexpr size_t WS_T1 = WS_QK, WS_MG = WS_V;
constexpr size_t WS_TOKE = 2 * MiB, WS_TOKW = 3 * MiB, WS_TOKLR = 4 * MiB, WS_TOKSLOT = 5 * MiB, WS_ROWTOK = 6 * MiB, WS_ROWW = 8 * MiB;
constexpr size_t WS_H1F = 10 * MiB;
constexpr size_t WS_W1 = 42 * MiB;
constexpr size_t WS_Y = 10 * MiB;
constexpr size_t WS_H = 319 * MiB;
constexpr size_t WS_W2 = 479 * MiB;
constexpr size_t WS_PST = 500 * MiB;
constexpr size_t WS_END = 512 * MiB;
static_assert(WS_WIN + (size_t)NPROJ * D * 2 <= WS_WGLA && WS_GB + (size_t)T * D * 2 <= 500 * MiB, "map 1");
static_assert(WS_ROWTOK + (size_t)ALL_ROWS * 4 <= WS_ROWW && WS_ROWW + (size_t)ALL_ROWS * 4 <= WS_H1F && WS_H1F + (size_t)T * D <= WS_W1, "map 2");
static_assert(WS_W1 + (size_t)65 * 512 * 1024 <= WS_H && WS_Y + (size_t)ROUTED_TILES * 256 * 1024 <= WS_H && WS_H + (size_t)ALL_ROWS * 256 <= WS_W2 && WS_W2 + (size_t)65 * 1024 * 256 <= WS_PST, "map 3");
constexpr int CW_TMO = 0, CW_CODE = 1;
constexpr int CW_BAR = 4096;
constexpr int MT_NT = 0, MT_ESTART = 16, MT_ECNT = 96;

constexpr int RING_OFF = 0, RING_BYTES = 131072;
constexpr int IDX_OFF = RING_BYTES, IDX_UNITS = 12, IDX_BYTES = IDX_UNITS * 1024;
constexpr int LDSCTL_OFF = IDX_OFF + IDX_BYTES, MISC_OFF = LDSCTL_OFF + 320;
constexpr int LDS_BYTES = 147456;
static_assert(MISC_OFF + 128 <= LDS_BYTES, "LDS map");

#define GAS __attribute__((address_space(1)))
#define LAS __attribute__((address_space(3)))
typedef unsigned short bf16;
typedef unsigned v4u __attribute__((ext_vector_type(4)));
typedef unsigned v2u __attribute__((ext_vector_type(2)));
typedef float f32x4 __attribute__((ext_vector_type(4)));
typedef float f32x2 __attribute__((ext_vector_type(2)));
typedef GAS unsigned gu32;
#define RLX_AGENT __ATOMIC_RELAXED, __HIP_MEMORY_SCOPE_AGENT
#define LDS_WAIT() asm volatile("s_waitcnt lgkmcnt(0)" ::: "memory")
#define VM_WAIT() asm volatile("s_waitcnt vmcnt(0)" ::: "memory")
__device__ __forceinline__ unsigned f2bf(float f) { unsigned u = __builtin_bit_cast(unsigned, f); return (u + 0x7fffu + ((u >> 16) & 1u)) >> 16; }
__device__ __forceinline__ unsigned pk2(float lo, float hi) { return f2bf(lo) | (f2bf(hi) << 16); }
__device__ __forceinline__ float bf2f(bf16 b) { return __uint_as_float((unsigned)b << 16); }
__device__ __forceinline__ float blo(unsigned w) { return __uint_as_float(w << 16); }
__device__ __forceinline__ float bhi(unsigned w) { return __uint_as_float(w & 0xffff0000u); }
__device__ __forceinline__ float sigmoidf_(float x) { return 1.0f / (1.0f + __expf(-x)); }

#define XB_TMO      128
#define XB_XCNT(j)  (256  + 64 * (j))
#define XB_XSUB(j)  (1280 + 64 * (j))
#define XB_XGEN(j)  (2304 + 64 * (j))
#define XB_TOP      3328
#define XB_TOPGEN   3392
#define XCD_BAR_WORDS 3456
#define XB_SPIN_CAP (1u << 18)

__device__ __forceinline__ unsigned xb_ld(unsigned* p)              { return __hip_atomic_load(p, __ATOMIC_RELAXED, __HIP_MEMORY_SCOPE_AGENT); }
__device__ __forceinline__ unsigned xb_add(unsigned* p, unsigned v) { return __hip_atomic_fetch_add(p, v, __ATOMIC_RELAXED, __HIP_MEMORY_SCOPE_AGENT); }
__device__ __forceinline__ unsigned xb_xcc_id() { return (unsigned)__builtin_amdgcn_s_getreg((3 << 11) | 20) & 0xFu; }
#define XB_SPIN(cond, bar) do { unsigned _sp = 0; while (cond) { __builtin_amdgcn_s_sleep(1); \
    if ((++_sp & 255u) == 0u) { if (xb_ld(&(bar)[XB_TMO])) break; if (_sp > XB_SPIN_CAP) { atomicAdd(&(bar)[XB_TMO], 1u); break; } } } } while (0)

struct XcdBarrier { unsigned* bar; unsigned x; volatile LAS unsigned* st; };

__device__ __forceinline__ XcdBarrier xcd_barrier_post(unsigned* bar, volatile LAS unsigned* st) {
    XcdBarrier b; b.bar = bar; b.x = xb_xcc_id(); b.st = st;
    if (threadIdx.x == 0) (void)xb_add(&bar[XB_XCNT(b.x)], 1u);
    return b;
}
__device__ __forceinline__ void xcd_barrier_complete(unsigned* bar, unsigned x, unsigned& nloc, unsigned& nx) {
    const unsigned G = gridDim.x * gridDim.y * gridDim.z;
    unsigned sum, cnt, mine, sp = 0u;
    for (;;) {
        sum = 0u; cnt = 0u; mine = 0u;
#pragma unroll
        for (unsigned j = 0; j < 16; ++j) { const unsigned c = xb_ld(&bar[XB_XCNT(j)]); sum += c; cnt += (c > 0u) ? 1u : 0u; mine = (j == x) ? c : mine; }
        if (sum == G) break;
        __builtin_amdgcn_s_sleep(1);
        if ((++sp & 255u) == 0u) { if (xb_ld(&bar[XB_TMO])) break; if (sp > XB_SPIN_CAP) { atomicAdd(&bar[XB_TMO], 1u); break; } }
    }
    nloc = mine > 0u ? mine : 1u; nx = cnt > 0u ? cnt : 1u;
}
__device__ __forceinline__ void xcd_barrier(const XcdBarrier& b) {
    asm volatile("s_waitcnt vmcnt(0)" ::: "memory");
    __syncthreads();
    if (threadIdx.x == 0) {
        unsigned* bar = b.bar;
        __builtin_amdgcn_s_waitcnt(0);
        unsigned nloc = b.st[0], nx = b.st[1];
        if (nloc == 0u) { xcd_barrier_complete(bar, b.x, nloc, nx); b.st[0] = nloc; b.st[1] = nx; }
        const unsigned old = xb_add(&bar[XB_XSUB(b.x)], 1u);
        const unsigned gen = old / nloc;
        if (old + 1u == (gen + 1u) * nloc) {
            __builtin_amdgcn_fence(__ATOMIC_RELEASE, "agent");
            asm volatile("s_waitcnt vmcnt(0)" ::: "memory");
            const unsigned og = xb_add(&bar[XB_TOP], 1u);
            const unsigned tg = og / nx;
            if (og + 1u == (tg + 1u) * nx) xb_add(&bar[XB_TOPGEN], 1u);
            else XB_SPIN(xb_ld(&bar[XB_TOPGEN]) == tg, bar);
            __builtin_amdgcn_fence(__ATOMIC_ACQUIRE, "agent");
            xb_add(&bar[XB_XGEN(b.x)], 1u);
            asm volatile("s_waitcnt vmcnt(0)" ::: "memory");
        } else {
            XB_SPIN(xb_ld(&bar[XB_XGEN(b.x)]) == gen, bar);
            __builtin_amdgcn_fence(__ATOMIC_ACQUIRE, "agent");
            asm volatile("s_waitcnt vmcnt(0)" ::: "memory");
        }
    }
    __syncthreads();
}

struct Frame {
    LAS unsigned char* lds;
    volatile LAS unsigned* MISC;
    gu32* ctl;
    unsigned char* ws;
    int tid, lane, wave;
    int vcu, G;
    const float *x, *w_in, *w_gate_up, *b_gate, *gla_norm_g, *w_gla_up, *w_pool_grp, *pool_scale, *w_pool_up, *w_out, *ln1_g, *ln1_b, *w_router, *router_bias,
                *w_exp_gate, *w_exp_up, *w_exp_down, *w_sh_gate, *w_sh_up, *w_sh_down, *ln2_g, *ln2_b;
    float* out;
};
template <int CTRL> __device__ __forceinline__ float dppf(float x) { return __builtin_bit_cast(float, __builtin_amdgcn_mov_dpp(__builtin_bit_cast(int, x), CTRL, 0xf, 0xf, true)); }
template <int CTRL> __device__ __forceinline__ int dppi(int x) { return __builtin_amdgcn_mov_dpp(x, CTRL, 0xf, 0xf, true); }
constexpr int DPP_XOR1 = 0xB1, DPP_XOR2 = 0x4E, DPP_ROR4 = 0x124, DPP_ROR8 = 0x128, DPP_Q0 = 0x00, DPP_Q1 = 0x55, DPP_Q2 = 0xAA, DPP_Q3 = 0xFF;
__device__ __forceinline__ float xrow16_sumf(float x) {
    auto s = __builtin_amdgcn_permlane16_swap(__float_as_uint(x), __float_as_uint(x), false, false);
    x = __uint_as_float(s[0]) + __uint_as_float(s[1]);
    auto t = __builtin_amdgcn_permlane32_swap(__float_as_uint(x), __float_as_uint(x), false, false);
    return __uint_as_float(t[0]) + __uint_as_float(t[1]);
}
__device__ __forceinline__ float wave_sum(float v) {
    v += dppf<DPP_XOR1>(v); v += dppf<DPP_XOR2>(v); v += dppf<DPP_ROR4>(v); v += dppf<DPP_ROR8>(v);
    return xrow16_sumf(v);
}
#define LDS_BARRIER() do { asm volatile("s_waitcnt lgkmcnt(0)" ::: "memory"); __builtin_amdgcn_s_barrier(); asm volatile("" ::: "memory"); } while (0)
typedef __bf16 bf16x2_t __attribute__((ext_vector_type(2)));
__device__ __forceinline__ unsigned cvtpk(float lo, float hi) { f32x2 v = {lo, hi}; bf16x2_t b = __builtin_convertvector(v, bf16x2_t); return __builtin_bit_cast(unsigned, b); }
__device__ __forceinline__ void tr_item(const float* W, int ldw, int k0, int n0s, bf16* WT, int ldd, int n0d, float scale, LAS float* scr, int lane) {
    float tv[32];
#pragma unroll
    for (int i = 0; i < 32; ++i) { const int kk = 2 * i + (lane >> 5); tv[i] = W[(size_t)(k0 + kk) * ldw + n0s + (lane & 31)]; }
#pragma unroll
    for (int i = 0; i < 32; ++i) { const int kk = 2 * i + (lane >> 5); scr[kk * 33 + (lane & 31)] = tv[i] * scale; }
    LDS_WAIT(); asm volatile("" ::: "memory");
    const int c = lane & 7;
#pragma unroll
    for (int j = 0; j < 4; ++j) { const int n = (lane >> 3) + 8 * j; const LAS float* s = scr + (8 * c) * 33 + n;
        v4u o; o.x = pk2(s[0 * 33], s[1 * 33]); o.y = pk2(s[2 * 33], s[3 * 33]); o.z = pk2(s[4 * 33], s[5 * 33]); o.w = pk2(s[6 * 33], s[7 * 33]);
        *(GAS v4u*)(WT + (size_t)(n0d + n) * ldd + k0 + 8 * c) = o; }
    LDS_WAIT(); asm volatile("" ::: "memory");
}

__device__ __forceinline__ void tr_item8(const float* W, int ldw, int k0, int n0s, unsigned char* WT, int ldd, int n0d, float scale, LAS float* scr, int lane) {
    float tv[32];
#pragma unroll
    for (int i = 0; i < 32; ++i) { const int kk = 2 * i + (lane >> 5); tv[i] = W[(size_t)(k0 + kk) * ldw + n0s + (lane & 31)]; }
#pragma unroll
    for (int i = 0; i < 32; ++i) { const int kk = 2 * i + (lane >> 5); scr[kk * 33 + (lane & 31)] = tv[i] * scale; }
    LDS_WAIT(); asm volatile("" ::: "memory");
#pragma unroll
    for (int j = 0; j < 2; ++j) { const int c = lane + 64 * j, n = c >> 2, kc = c & 3; const LAS float* sp = scr + (16 * kc) * 33 + n;
        v4u o; o.x = pg8::pk4_fp8(sp[0 * 33], sp[1 * 33], sp[2 * 33], sp[3 * 33]); o.y = pg8::pk4_fp8(sp[4 * 33], sp[5 * 33], sp[6 * 33], sp[7 * 33]);
        o.z = pg8::pk4_fp8(sp[8 * 33], sp[9 * 33], sp[10 * 33], sp[11 * 33]); o.w = pg8::pk4_fp8(sp[12 * 33], sp[13 * 33], sp[14 * 33], sp[15 * 33]);
        *(GAS v4u*)(WT + (size_t)(n0d + n) * ldd + k0 + 16 * kc) = o; }
    LDS_WAIT(); asm volatile("" ::: "memory");
}
__device__ __forceinline__ void router_prep(Frame& F);
__device__ __forceinline__ void p0_prologue(Frame& F) {
    LAS float* scr = (LAS float*)(F.lds + RING_OFF + F.wave * 16384);
    const int gw = F.vcu * NWAVES + F.wave, NGW = F.G * NWAVES;
    bf16* Win = (bf16*)(F.ws + WS_WIN); bf16* Wgla = (bf16*)(F.ws + WS_WGLA); bf16* Wpc = (bf16*)(F.ws + WS_WPC); bf16* Wout = (bf16*)(F.ws + WS_WOUT);
    constexpr int I_IN = 16 * (NPROJ / 32), I_SQ = 16 * 32;
    for (int it = gw; it < I_IN + 2 * I_SQ; it += NGW) {
        int r = it;
        if (r < I_IN) { const int kb = r / (NPROJ / 32), nb = r % (NPROJ / 32), n0d = 32 * nb, n0s = n0d < 3072 ? n0d : n0d + 16;
            tr_item(F.w_in, IN_COLS, 64 * kb, n0s, Win, D, n0d, n0d < 512 ? 0.08838834764831845f : 1.0f, scr, F.lane); continue; }
        r -= I_IN;
        if (r < I_SQ) { tr_item(F.w_gla_up, D, 64 * (r / 32), 32 * (r % 32), Wgla, D, 32 * (r % 32), 1.0f, scr, F.lane); continue; }
        r -= I_SQ;
        tr_item(F.w_out, D, 64 * (r / 32), 32 * (r % 32), Wout, D, 32 * (r % 32), 1.0f, scr, F.lane);
    }
    __syncthreads();
    for (int it = F.vcu; it < 4 * 32; it += F.G) {
        const int g = it >> 5, n0 = (it & 31) * 32;
        LAS float* As = (LAS float*)(F.lds + RING_OFF); LAS float* Bs = As + 128 * 129;
        for (int i = F.tid; i < 128 * 128; i += NWAVES * 64) { const int c = i >> 7, e = i & 127; As[c * 129 + e] = F.w_pool_grp[(size_t)(g * 128 + c) * 128 + e] * F.pool_scale[g * 128 + e]; }
        for (int i = F.tid; i < 128 * 32; i += NWAVES * 64) { const int e = i >> 5, n = i & 31; Bs[e * 33 + n] = F.w_pool_up[(size_t)(g * 128 + e) * D + n0 + n]; }
        __syncthreads();
        { const int n = F.tid & 31, cg = F.tid >> 5; float a[8];
#pragma unroll
          for (int i = 0; i < 8; ++i) a[i] = 0.f;
#pragma unroll 4
          for (int e = 0; e < 128; ++e) { const float bv = Bs[e * 33 + n];
#pragma unroll
              for (int i = 0; i < 8; ++i) a[i] += As[(8 * cg + i) * 129 + e] * bv; }
          v4u o; o.x = pk2(a[0], a[1]); o.y = pk2(a[2], a[3]); o.z = pk2(a[4], a[5]); o.w = pk2(a[6], a[7]);
          *(GAS v4u*)(Wpc + (size_t)(n0 + n) * PW + g * 128 + 8 * cg) = o; }
        __syncthreads();
    }
    router_prep(F);
    __syncthreads();
    { LAS v4u* wf = (LAS v4u*)(F.lds + RING_OFF);
      for (int id = F.tid; id < 32 * 2 * 64; id += NWAVES * 64) { const int ln = id & 63, pp = (id >> 6) & 1, ks = id >> 7, r = ln & 15, dbase = 32 * ks + 8 * (ln >> 4);
          float v[8];
#pragma unroll
          for (int j = 0; j < 8; ++j) { const float w = F.w_in[(size_t)(dbase + j) * IN_COLS + 3072 + r]; const float hi = __uint_as_float(f2bf(w) << 16); v[j] = pp ? (w - hi) : w; }
          v4u o; o.x = pk2(v[0], v[1]); o.y = pk2(v[2], v[3]); o.z = pk2(v[4], v[5]); o.w = pk2(v[6], v[7]); wf[id] = o; }
      __syncthreads();
      bf16* XB = (bf16*)(F.ws + WS_XB); float* GLR = (float*)(F.ws + WS_GLR);
      const int row = F.lane & 15, kg = F.lane >> 4;
      for (int tile = gw; tile < T / 16; tile += NGW) {
          const int t0 = tile * 16;
          const GAS f32x4* xp = (const GAS f32x4*)(F.x + (size_t)(t0 + row) * D + 8 * kg);
          GAS v4u* ob = (GAS v4u*)(XB + (size_t)(t0 + row) * D + 8 * kg);
          pg8::f32x4 acc = (pg8::f32x4){0.f, 0.f, 0.f, 0.f};
#pragma unroll 8
          for (int ks = 0; ks < 32; ++ks) {
              const f32x4 x0 = xp[8 * ks], x1 = xp[8 * ks + 1];
              v4u ah; ah.x = cvtpk(x0.x, x0.y); ah.y = cvtpk(x0.z, x0.w); ah.z = cvtpk(x1.x, x1.y); ah.w = cvtpk(x1.z, x1.w);
              v4u al; al.x = cvtpk(x0.x - blo(ah.x), x0.y - bhi(ah.x)); al.y = cvtpk(x0.z - blo(ah.y), x0.w - bhi(ah.y)); al.z = cvtpk(x1.x - blo(ah.z), x1.y - bhi(ah.z)); al.w = cvtpk(x1.z - blo(ah.w), x1.w - bhi(ah.w));
#ifdef NT_XB
              __builtin_nontemporal_store(ah, ob + 4 * ks);
#else
              ob[4 * ks] = ah;
#endif
              const pg8::bf16x8 Ah = __builtin_bit_cast(pg8::bf16x8, ah), Al = __builtin_bit_cast(pg8::bf16x8, al);
              const pg8::bf16x8 bh = __builtin_bit_cast(pg8::bf16x8, wf[(ks * 2 + 0) * 64 + F.lane]), bl = __builtin_bit_cast(pg8::bf16x8, wf[(ks * 2 + 1) * 64 + F.lane]);
              acc = __builtin_amdgcn_mfma_f32_16x16x32_bf16(Ah, bh, acc, 0, 0, 0);
              acc = __builtin_amdgcn_mfma_f32_16x16x32_bf16(Al, bh, acc, 0, 0, 0);
              acc = __builtin_amdgcn_mfma_f32_16x16x32_bf16(Ah, bl, acc, 0, 0, 0);
          }
#pragma unroll
          for (int r = 0; r < 4; ++r) GLR[(size_t)(t0 + 4 * kg + r) * GRANK + row] = acc[r];
      }
    }
}

template <int WIN> __device__ __forceinline__ void pool_item(const bf16* U, bf16* PO, int t, int c8) {
    const int pos = t & (SEQ - 1);
    v4u w[WIN];
#pragma unroll
    for (int j = 0; j < WIN; ++j) { const int tj = (j <= pos) ? t - j : t; w[j] = *(const GAS v4u*)(U + (size_t)tj * PW + c8 * 8); }
    float s[8];
#pragma unroll
    for (int q = 0; q < 8; ++q) s[q] = 0.f;
#pragma unroll
    for (int j = 0; j < WIN; ++j) { const float m = (j <= pos) ? 1.f : 0.f;
        s[0] += m * blo(w[j].x); s[1] += m * bhi(w[j].x); s[2] += m * blo(w[j].y); s[3] += m * bhi(w[j].y); s[4] += m * blo(w[j].z); s[5] += m * bhi(w[j].z); s[6] += m * blo(w[j].w); s[7] += m * bhi(w[j].w); }
    const int cnt = (pos + 1 < WIN) ? pos + 1 : WIN; const float ic = 1.0f / (float)cnt; const v4u cur = w[0];
    v4u o; o.x = pk2(s[0] * ic - blo(cur.x), s[1] * ic - bhi(cur.x)); o.y = pk2(s[2] * ic - blo(cur.y), s[3] * ic - bhi(cur.y));
    o.z = pk2(s[4] * ic - blo(cur.z), s[5] * ic - bhi(cur.z)); o.w = pk2(s[6] * ic - blo(cur.w), s[7] * ic - bhi(cur.w));
#ifdef NT_MISC
    __builtin_nontemporal_store(o, (GAS v4u*)(PO + (size_t)t * PW + c8 * 8));
#else
    *(GAS v4u*)(PO + (size_t)t * PW + c8 * 8) = o;
#endif
}
template <int WIN> __device__ __forceinline__ void pool_loop(Frame& F, const bf16* U, bf16* PO, int grp) {
    const int gw = F.vcu * NWAVES + F.wave, NGW = F.G * NWAVES;
#pragma unroll 2
    for (int it = gw; it < (T / 4) * 4; it += NGW) pool_item<WIN>(U, PO, (it >> 2) * 4 + (F.lane >> 4), grp * 16 + (F.lane & 15));
}
__device__ __forceinline__ void pool_phase(Frame& F) {
    const bf16* U = (const bf16*)(F.ws + WS_U); bf16* PO = (bf16*)(F.ws + WS_PO);
    const int grp = (F.vcu * NWAVES + F.wave) & 3;
    if ((F.G * NWAVES) & 3) {
        const int gw = F.vcu * NWAVES + F.wave, NGW = F.G * NWAVES;
        for (int it = gw; it < (T / 4) * 4; it += NGW) { const int tq = it >> 2, g2 = it & 3, t = tq * 4 + (F.lane >> 4), c8 = g2 * 16 + (F.lane & 15);
            if (g2 == 0) pool_item<2>(U, PO, t, c8); else if (g2 == 1) pool_item<4>(U, PO, t, c8); else if (g2 == 2) pool_item<8>(U, PO, t, c8); else pool_item<16>(U, PO, t, c8); }
        return;
    }
    if (grp == 0) pool_loop<2>(F, U, PO, 0); else if (grp == 1) pool_loop<4>(F, U, PO, 1); else if (grp == 2) pool_loop<8>(F, U, PO, 2); else pool_loop<16>(F, U, PO, 3);
}

__device__ __forceinline__ void expert_w1_phase(Frame& F) {
    LAS float* scr = (LAS float*)(F.lds + RING_OFF + F.wave * 16384);
    const int gw = F.vcu * NWAVES + F.wave, NGW = F.G * NWAVES;
    unsigned char* W1 = F.ws + WS_W1;
    for (int it = gw; it < 65 * 2 * 128; it += NGW) {
        const int e = it >> 8, mat = (it >> 7) & 1, kb = (it >> 3) & 15, nb = it & 7, f0 = 32 * nb;
        const float* src = (e < NE) ? ((mat ? F.w_exp_up : F.w_exp_gate) + (size_t)e * D * FF) : (mat ? F.w_sh_up : F.w_sh_gate);
        tr_item8(src, FF, 64 * kb, f0, W1 + (size_t)e * 512 * D, D, 256 * (f0 >> 7) + (f0 & 127) + 128 * mat, W_SCALE, scr, F.lane);
    }
}
__device__ __forceinline__ void expert_w2_phase(Frame& F) {
    LAS float* scr = (LAS float*)(F.lds + RING_OFF + F.wave * 16384);
    const int gw = F.vcu * NWAVES + F.wave, NGW = F.G * NWAVES;
    unsigned char* W2 = F.ws + WS_W2;
    for (int it = gw; it < 65 * 128; it += NGW) {
        const int e = it >> 7, kb = (it >> 5) & 3, nb = it & 31;
        const float* src = (e < NE) ? (F.w_exp_down + (size_t)e * FF * D) : F.w_sh_down;
        tr_item8(src, D, 64 * kb, 32 * nb, W2 + (size_t)e * D * FF, FF, 32 * nb, W_SCALE, scr, F.lane);
    }
}

constexpr size_t TAB_WRT = WS_TAB + 524288, TAB_CGB = WS_TAB + 786432;
__device__ __forceinline__ void router_prep(Frame& F) {
    v4u* WRT = (v4u*)(F.ws + TAB_WRT);
    const int gt = F.vcu * (NWAVES * 64) + F.tid, NT = F.G * NWAVES * 64;
    for (int id = gt; id < 32 * 4 * 2 * 64; id += NT) {
        const int ln = id & 63, p = (id >> 6) & 1, nt = (id >> 7) & 3, ks = id >> 9, e = 16 * nt + (ln & 15), dbase = 32 * ks + 8 * (ln >> 4);
        float v[8];
#pragma unroll
        for (int j = 0; j < 8; ++j) { const float w = F.w_router[(size_t)(dbase + j) * NE + e]; const float hi = __uint_as_float(f2bf(w) << 16); v[j] = p ? (w - hi) : w; }
        v4u o; o.x = pk2(v[0], v[1]); o.y = pk2(v[2], v[3]); o.z = pk2(v[4], v[5]); o.w = pk2(v[6], v[7]);
        WRT[id] = o;
    }
}
__device__ __forceinline__ void router_phase(Frame& F) {
    const bf16* PRE = (const bf16*)F.out; unsigned char* H1F = F.ws + WS_H1F; float* ST = (float*)(F.ws + TAB_STATS); const float* PST = (const float*)(F.ws + WS_PST);
    int* TOKE = (int*)(F.ws + WS_TOKE); float* TOKW = (float*)(F.ws + WS_TOKW); int* TOKLR = (int*)(F.ws + WS_TOKLR); int* CNT = (int*)(F.ws + TAB_CNT);
    const v4u* WRT = (const v4u*)(F.ws + TAB_WRT);
    LAS float* lgt = (LAS float*)(F.lds + F.wave * 4096);
    LAS int* lcnt = (LAS int*)(F.lds + LDSCTL_OFF);
    LAS float* lgb = (LAS float*)(F.lds + IDX_OFF);
    const int lane = F.lane, row = lane & 15, kg = lane >> 4, q = lane & 3;
    for (int i = F.tid; i < 2 * D; i += NWAVES * 64) lgb[i] = i < D ? F.ln1_g[i] : F.ln1_b[i - D];
    for (int tile = F.vcu; tile < T / 128; tile += F.G) {
        if (F.tid < 64) lcnt[F.tid] = 0;
        __syncthreads();
        const int t0 = tile * 128 + F.wave * 16;
        float mean, rstd;
        { const GAS f32x4* pp = (const GAS f32x4*)(PST + (size_t)(t0 + row) * 32); float s1 = 0.f, s2 = 0.f;
#pragma unroll
          for (int i = 0; i < 8; ++i) { const f32x4 v = pp[i]; s1 += v.x + v.z; s2 += v.y + v.w; }
          mean = s1 * (1.f / D); rstd = 1.f / sqrtf(fmaxf(s2 * (1.f / D) - mean * mean, 0.f) + LN_EPS); }
        if (kg == 0) *(GAS f32x2*)(ST + 2 * (size_t)(t0 + row)) = (f32x2){mean, rstd};
        pg8::f32x4 acc[4];
#pragma unroll
        for (int nt = 0; nt < 4; ++nt) acc[nt] = (pg8::f32x4){0.f, 0.f, 0.f, 0.f};
        const GAS v4u* xp = (const GAS v4u*)(PRE + (size_t)(t0 + row) * 2048 + 8 * kg);
        GAS v2u* ob = (GAS v2u*)(H1F + (size_t)(t0 + row) * D + 8 * kg);
        LAS v4u* wl = (LAS v4u*)(F.lds + RING_OFF);
#pragma unroll 1
        for (int kh = 0; kh < 2; ++kh) {
            { const GAS v4u* src = (const GAS v4u*)WRT + (size_t)kh * 8192 + F.tid; v4u tmp[16];
#pragma unroll
              for (int i = 0; i < 16; ++i) tmp[i] = src[i * 512];
#pragma unroll
              for (int i = 0; i < 16; ++i) wl[F.tid + i * 512] = tmp[i]; }
            __syncthreads();
#pragma unroll 8
            for (int kl = 0; kl < 16; ++kl) {
                const int ks = kh * 16 + kl;
                const v4u xw = xp[4 * ks]; f32x4 x0 = (f32x4){blo(xw.x), bhi(xw.x), blo(xw.y), bhi(xw.y)}, x1 = (f32x4){blo(xw.z), bhi(xw.z), blo(xw.w), bhi(xw.w)};
                const f32x4 g0 = *(const LAS f32x4*)(lgb + 32 * ks + 8 * kg), g1 = *(const LAS f32x4*)(lgb + 32 * ks + 8 * kg + 4), b0 = *(const LAS f32x4*)(lgb + D + 32 * ks + 8 * kg), b1 = *(const LAS f32x4*)(lgb + D + 32 * ks + 8 * kg + 4);
                x0 = (x0 - mean) * rstd * g0 + b0; x1 = (x1 - mean) * rstd * g1 + b1;
                v4u ah; ah.x = cvtpk(x0.x, x0.y); ah.y = cvtpk(x0.z, x0.w); ah.z = cvtpk(x1.x, x1.y); ah.w = cvtpk(x1.z, x1.w);
                v4u al; al.x = cvtpk(x0.x - blo(ah.x), x0.y - bhi(ah.x)); al.y = cvtpk(x0.z - blo(ah.y), x0.w - bhi(ah.y)); al.z = cvtpk(x1.x - blo(ah.z), x1.y - bhi(ah.z)); al.w = cvtpk(x1.z - blo(ah.w), x1.w - bhi(ah.w));
#ifdef NT_MISC
                __builtin_nontemporal_store((v2u){pg8::pk4_fp8(x0.x, x0.y, x0.z, x0.w), pg8::pk4_fp8(x1.x, x1.y, x1.z, x1.w)}, ob + 4 * ks);
#else
                ob[4 * ks] = (v2u){pg8::pk4_fp8(x0.x, x0.y, x0.z, x0.w), pg8::pk4_fp8(x1.x, x1.y, x1.z, x1.w)};
#endif
                const pg8::bf16x8 Ah = __builtin_bit_cast(pg8::bf16x8, ah), Al = __builtin_bit_cast(pg8::bf16x8, al);
#pragma unroll
                for (int nt = 0; nt < 4; ++nt) { const pg8::bf16x8 bh = __builtin_bit_cast(pg8::bf16x8, wl[((kl * 4 + nt) * 2 + 0) * 64 + lane]), bl = __builtin_bit_cast(pg8::bf16x8, wl[((kl * 4 + nt) * 2 + 1) * 64 + lane]);
                    acc[nt] = __builtin_amdgcn_mfma_f32_16x16x32_bf16(Ah, bh, acc[nt], 0, 0, 0);
                    acc[nt] = __builtin_amdgcn_mfma_f32_16x16x32_bf16(Al, bh, acc[nt], 0, 0, 0);
                    acc[nt] = __builtin_amdgcn_mfma_f32_16x16x32_bf16(Ah, bl, acc[nt], 0, 0, 0); }
            }
            __syncthreads();
        }
#pragma unroll
        for (int r = 0; r < 4; ++r)
#pragma unroll
            for (int nt = 0; nt < 4; ++nt) lgt[(4 * kg + r) * 64 + 16 * nt + row] = acc[nt][r];
        LDS_WAIT(); asm volatile("" ::: "memory");
        {
            const int tk = lane >> 2, t = t0 + tk;
            float sc[16], mb[16];
#pragma unroll
            for (int i4 = 0; i4 < 4; ++i4) { const f32x4 l4 = *(const LAS f32x4*)(lgt + tk * 64 + 16 * q + 4 * i4); const f32x4 b4 = *(const GAS f32x4*)(F.router_bias + 16 * q + 4 * i4);
                sc[4 * i4] = 1.0f / (1.0f + expf(-l4.x)); sc[4 * i4 + 1] = 1.0f / (1.0f + expf(-l4.y)); sc[4 * i4 + 2] = 1.0f / (1.0f + expf(-l4.z)); sc[4 * i4 + 3] = 1.0f / (1.0f + expf(-l4.w));
                mb[4 * i4] = sc[4 * i4] + b4.x; mb[4 * i4 + 1] = sc[4 * i4 + 1] + b4.y; mb[4 * i4 + 2] = sc[4 * i4 + 2] + b4.z; mb[4 * i4 + 3] = sc[4 * i4 + 3] + b4.w; }
            float gs0, gs1;
            { float m1 = -INFINITY, m2 = -INFINITY;
#pragma unroll
              for (int i = 0; i < 8; ++i) { const float v = mb[i]; m2 = fmaxf(m2, fminf(m1, v)); m1 = fmaxf(m1, v); }
              gs0 = m1 + m2; m1 = -INFINITY; m2 = -INFINITY;
#pragma unroll
              for (int i = 8; i < 16; ++i) { const float v = mb[i]; m2 = fmaxf(m2, fminf(m1, v)); m1 = fmaxf(m1, v); }
              gs1 = m1 + m2; }
            float G8[8];
            G8[0] = dppf<DPP_Q0>(gs0); G8[1] = dppf<DPP_Q0>(gs1); G8[2] = dppf<DPP_Q1>(gs0); G8[3] = dppf<DPP_Q1>(gs1); G8[4] = dppf<DPP_Q2>(gs0); G8[5] = dppf<DPP_Q2>(gs1); G8[6] = dppf<DPP_Q3>(gs0); G8[7] = dppf<DPP_Q3>(gs1);
            int rk0 = 0, rk1 = 0;
#pragma unroll
            for (int g = 0; g < 8; ++g) { rk0 += (G8[g] > gs0 || (G8[g] == gs0 && g < 2 * q)) ? 1 : 0; rk1 += (G8[g] > gs1 || (G8[g] == gs1 && g < 2 * q + 1)) ? 1 : 0; }
            const bool sel0 = rk0 < 4, sel1 = rk1 < 4;
#pragma unroll
            for (int i = 0; i < 8; ++i) { mb[i] = sel0 ? mb[i] : -INFINITY; mb[8 + i] = sel1 ? mb[8 + i] : -INFINITY; }
            int eidx[8]; float esc[8]; float ssum = 0.f;
#pragma unroll
            for (int k = 0; k < TOPK; ++k) {
                float lm = mb[0]; int li = 0;
#pragma unroll
                for (int i = 1; i < 16; ++i) { const bool gt = mb[i] > lm; lm = gt ? mb[i] : lm; li = gt ? i : li; }
                float m = fmaxf(lm, dppf<DPP_XOR1>(lm)); m = fmaxf(m, dppf<DPP_XOR2>(m));
                int cand = (lm == m) ? 16 * q + li : 9999;
                int widx = min(cand, dppi<DPP_XOR1>(cand)); widx = min(widx, dppi<DPP_XOR2>(widx));
                const bool mine = (cand == widx); float sv = 0.f;
#pragma unroll
                for (int i = 0; i < 16; ++i) { const bool hit = mine && (i == li); sv = hit ? sc[i] : sv; mb[i] = hit ? -INFINITY : mb[i]; }
                sv += dppf<DPP_XOR1>(sv); sv += dppf<DPP_XOR2>(sv);
                eidx[k] = widx; esc[k] = sv; ssum += sv;
            }
            const float inv = ROUTE_SCALE / ssum;
            const int e0 = q == 0 ? eidx[0] : q == 1 ? eidx[2] : q == 2 ? eidx[4] : eidx[6], e1 = q == 0 ? eidx[1] : q == 1 ? eidx[3] : q == 2 ? eidx[5] : eidx[7];
            const float w0 = (q == 0 ? esc[0] : q == 1 ? esc[2] : q == 2 ? esc[4] : esc[6]) * inv, w1 = (q == 0 ? esc[1] : q == 1 ? esc[3] : q == 2 ? esc[5] : esc[7]) * inv;
            const int lr0 = __hip_atomic_fetch_add(&lcnt[e0], 1, __ATOMIC_RELAXED, __HIP_MEMORY_SCOPE_WORKGROUP), lr1 = __hip_atomic_fetch_add(&lcnt[e1], 1, __ATOMIC_RELAXED, __HIP_MEMORY_SCOPE_WORKGROUP);
            const size_t o = (size_t)t * 8 + 2 * q;
            *(GAS v2u*)(TOKE + o) = (v2u){(unsigned)e0, (unsigned)e1}; *(GAS f32x2*)(TOKW + o) = (f32x2){w0, w1}; *(GAS v2u*)(TOKLR + o) = (v2u){(unsigned)lr0, (unsigned)lr1};
        }
        __syncthreads();
        if (F.tid < 64) CNT[tile * 64 + F.tid] = lcnt[F.tid];
        __syncthreads();
    }
}

__device__ __forceinline__ void assign_phase(Frame& F) {
    const int* CNT = (const int*)(F.ws + TAB_CNT); int* TILEE = (int*)(F.ws + TAB_TILEE); int* META = (int*)(F.ws + TAB_META);
    const int* TOKE = (const int*)(F.ws + WS_TOKE); const float* TOKW = (const float*)(F.ws + WS_TOKW); const int* TOKLR = (const int*)(F.ws + WS_TOKLR);
    int* TOKSLOT = (int*)(F.ws + WS_TOKSLOT); int* ROWTOK = (int*)(F.ws + WS_ROWTOK); float* ROWW = (float*)(F.ws + WS_ROWW);
    LAS int* lpart = (LAS int*)(F.lds); LAS int* ltot = lpart + 512 * 2; LAS int* lbase = ltot + 64; LAS int* lseg = lbase + 64; LAS int* lnt = lseg + 64;
    bool first = true;
    for (int tile = F.vcu; tile < T / 128; tile += F.G) {
        { const int e = F.tid & 63, part = F.tid >> 6; int tot = 0, bs = 0;
#pragma unroll 8
          for (int tt = part * 32; tt < part * 32 + 32; ++tt) { const int c = CNT[tt * 64 + e]; tot += c; bs += (tt < tile) ? c : 0; }
          lpart[(part * 64 + e) * 2] = tot; lpart[(part * 64 + e) * 2 + 1] = bs; }
        __syncthreads();
        if (F.tid < 64) { int tot = 0, bs = 0;
#pragma unroll
            for (int part = 0; part < 8; ++part) { tot += lpart[(part * 64 + F.tid) * 2]; bs += lpart[(part * 64 + F.tid) * 2 + 1]; }
            ltot[F.tid] = tot; lbase[F.tid] = bs; }
        __syncthreads();
        if (F.tid == 0) { int run = 0;
            for (int e = 0; e < NE; ++e) { lseg[e] = run; run += (ltot[e] + 255) & ~255; }
            lnt[0] = run >> 8; }
        __syncthreads();
#pragma unroll
        for (int q = 0; q < 2; ++q) { const int idx = F.tid + q * 512; const size_t tk = (size_t)tile * 1024 + idx; const int e = TOKE[tk];
            const int slot = lseg[e] + lbase[e] + TOKLR[tk];
            TOKSLOT[tk] = slot; ROWTOK[slot] = (int)(tk >> 3); ROWW[slot] = TOKW[tk]; }
        if (first) {
            first = false;
            for (int p = F.vcu; p < NE; p += F.G) { const int seg = lseg[p], tot = ltot[p], pad = (tot + 255) & ~255;
                for (int r = seg + tot + F.tid; r < seg + pad; r += NWAVES * 64) { ROWTOK[r] = 0; ROWW[r] = 0.f; }
                for (int tl = (seg >> 8) + F.tid; tl < ((seg + pad) >> 8); tl += NWAVES * 64) TILEE[tl] = p;
                if (F.tid == 0) { META[MT_ESTART + p] = seg >> 8; META[MT_ECNT + p] = pad >> 8; } }
            if (F.vcu == 0 && F.tid == 0) META[MT_NT] = lnt[0];
            for (int i = F.vcu * (NWAVES * 64) + F.tid; i < T; i += F.G * NWAVES * 64) { ROWTOK[ROUTED_TILES * 256 + i] = i; ROWW[ROUTED_TILES * 256 + i] = 1.0f; }
        }
        __syncthreads();
    }
}

struct Moe1Order {
    const int* tile_e; int nt, G, c;
    __device__ __forceinline__ bool next(int i, pg8::Unit& u) const {
        const int nR = 2 * nt, nU = nR + 2 * SH_TILES; const long Lr = (long)i * G + c; if (Lr >= nU) return false;
        const int L = pg8::xcd_remap((int)Lr, nU);
        int rt, e; const int pn = L & 1;
        if (L < nR) { rt = L >> 1; e = tile_e[rt]; } else { rt = ROUTED_TILES + ((L - nR) >> 1); e = NE; }
        u.pm = rt; u.pn = pn; u.at = rt; u.bt = e * 2 + pn; return true;
    }
    __device__ __forceinline__ int row_tile(int i) const {
        const int nR = 2 * nt, nU = nR + 2 * SH_TILES; const long Lr = (long)i * G + c; if (Lr >= nU) return -1;
        const int L = pg8::xcd_remap((int)Lr, nU); return L < nR ? (L >> 1) : ROUTED_TILES + ((L - nR) >> 1);
    }
};
struct Moe2Order {
    const int* tile_e; int nt, G, c;
    __device__ __forceinline__ bool next(int i, pg8::Unit& u) const {
        const int nU = 4 * nt; const long Lr = (long)i * G + c; if (Lr >= nU) return false;
        const int L = pg8::xcd_remap((int)Lr, nU);
        const int rt = L >> 2, pn = L & 3, e = tile_e[rt];
        u.pm = rt; u.pn = pn; u.at = rt; u.bt = e * 4 + pn; return true;
    }
};

#if defined(WT_M2)
#define M2_ST(p_, v_) pg8::st16_wt((void*)(p_), __builtin_bit_cast(pg8::u32x4, v_))
#else
#define M2_ST(p_, v_) __builtin_nontemporal_store(v_, (GAS v4u*)(p_))
#endif
__device__ __forceinline__ void moe2_stationary_phase(Frame& F) {
    const int* META = (const int*)(F.ws + TAB_META);
    const unsigned char* H = F.ws + WS_H; const unsigned char* W2 = F.ws + WS_W2; unsigned char* Y = F.ws + WS_Y;
    int lx = F.lane; asm volatile("" : "+v"(lx));
    const int w = F.wave, fr = lx & 15, fq = lx >> 4, cg = w & 3, rg = w >> 2;
    int f8sa = 0x01010101 * (127 - 5), f8sb = 0x7f7f7f7f; asm volatile("" : "+v"(f8sa), "+v"(f8sb));
    const int aoff = pg8::lds_byte(rg * 64 + fr, fq * 8);
    unsigned voff[2];
#pragma unroll
    for (int i = 0; i < 2; ++i) { int R, C; pg8::stage_rc((w * 64 + lx) * 16 + i * 8192, R, C); voff[i] = (unsigned)(R * 256 + C * 2); }
    const unsigned ldsw = (unsigned)w * 1024u;
#define M2_STAGE(slot, rowbase) do { const unsigned char* g_ = H + (size_t)(rowbase) * 256; _Pragma("unroll") for (int kt_ = 0; kt_ < 2; ++kt_) _Pragma("unroll") for (int i_ = 0; i_ < 2; ++i_) \
        __builtin_amdgcn_global_load_lds((const unsigned*)(g_ + voff[i_] + kt_ * 128), (LAS unsigned*)(F.lds + RING_OFF + (slot) * 32768 + kt_ * 16384 + ldsw + i_ * 8192), 16, 0, 0); } while (0)
    for (int pair = F.vcu; pair < 4 * NE; pair += F.G) {
        const int e = pair >> 2, pn = pair & 3, t0 = META[MT_ESTART + e], ntl = META[MT_ECNT + e], nhp = 2 * ntl;
        if (nhp == 0) continue;
        pg8::i32x8 Bf[4][2];
#pragma unroll
        for (int nf = 0; nf < 4; ++nf)
#pragma unroll
            for (int kt = 0; kt < 2; ++kt) { const unsigned char* bp = W2 + ((size_t)e * D + pn * 256 + cg * 64 + 16 * (fr >> 2) + 4 * nf + (fr & 3)) * FF + kt * 128 + 16 * fq;
                const pg8::i32x4 lo = *(const GAS pg8::i32x4*)bp, hi = *(const GAS pg8::i32x4*)(bp + 64); Bf[nf][kt] = __builtin_shufflevector(lo, hi, 0, 1, 2, 3, 4, 5, 6, 7); }
        asm volatile("s_waitcnt vmcnt(0)" ::: "memory");
        __syncthreads();
        const int rb0 = t0 * 256;
        M2_STAGE(0, rb0); M2_STAGE(1, rb0 + (nhp > 1 ? 128 : 0));
        for (int p = 0; p < nhp; ++p) {
            if (p == 0) asm volatile("s_waitcnt vmcnt(4)" ::: "memory"); else if (p == 1) asm volatile("s_waitcnt vmcnt(8)" ::: "memory"); else asm volatile("s_waitcnt vmcnt(12)" ::: "memory");
            __builtin_amdgcn_s_barrier(); asm volatile("" ::: "memory");
            { const int pnx = (p + 2 < nhp) ? p + 2 : p; M2_STAGE((p + 2) % 3, rb0 + pnx * 128); }
            const int slot = p % 3; const unsigned sb = (unsigned)(RING_OFF + slot * 32768);
            pg8::f32x4 acc[4][4];
#pragma unroll
            for (int kt = 0; kt < 2; ++kt)
#pragma unroll
                for (int m = 0; m < 4; ++m) { pg8::i32x8 Af;
                    { const pg8::i32x4 lo = *(const LAS pg8::i32x4*)(F.lds + sb + kt * 16384 + aoff + m * 2048), hi = *(const LAS pg8::i32x4*)(F.lds + sb + kt * 16384 + aoff + m * 2048 + 1024); Af = __builtin_shufflevector(lo, hi, 0, 1, 2, 3, 4, 5, 6, 7); }
#pragma unroll
                    for (int nf = 0; nf < 4; ++nf) {
                        if (kt == 0) asm volatile("v_mfma_scale_f32_16x16x128_f8f6f4 %0, %1, %2, 0, %3, %4 op_sel_hi:[0,0,0]" : "=&v"(acc[m][nf]) : "v"(Bf[nf][kt]), "v"(Af), "v"(f8sa), "v"(f8sb));
                        else         asm volatile("v_mfma_scale_f32_16x16x128_f8f6f4 %0, %1, %2, %0, %3, %4 op_sel_hi:[0,0,0]" : "+v"(acc[m][nf]) : "v"(Bf[nf][kt]), "v"(Af), "v"(f8sa), "v"(f8sb)); } }
            asm volatile("s_nop 15\n\ts_nop 15" : "+v"(acc[3][0]), "+v"(acc[3][1]), "+v"(acc[3][2]), "+v"(acc[3][3]) :: "memory");
            LAS unsigned char* stg = F.lds + RING_OFF + 3 * 32768;
#pragma unroll
            for (int m = 0; m < 4; ++m) { v4u o;
                o.x = pg8::pk4_fp8(acc[m][0][0], acc[m][0][1], acc[m][0][2], acc[m][0][3]); o.y = pg8::pk4_fp8(acc[m][1][0], acc[m][1][1], acc[m][1][2], acc[m][1][3]);
                o.z = pg8::pk4_fp8(acc[m][2][0], acc[m][2][1], acc[m][2][2], acc[m][2][3]); o.w = pg8::pk4_fp8(acc[m][3][0], acc[m][3][1], acc[m][3][2], acc[m][3][3]);
                *(LAS v4u*)(stg + (rg * 64 + 16 * m + fr) * 272 + cg * 64 + 16 * fq) = o; }
            asm volatile("s_waitcnt lgkmcnt(0)" ::: "memory"); __builtin_amdgcn_s_barrier(); asm volatile("" ::: "memory");
            { const size_t rowb = (size_t)rb0 + (size_t)p * 128 + 16 * w;
#pragma unroll
              for (int i = 0; i < 4; ++i) { const int rl = 4 * i + (lx >> 4); const v4u o = *(const LAS v4u*)(stg + (16 * w + rl) * 272 + 16 * (lx & 15));
                  M2_ST((Y + (rowb + rl) * D + pn * 256 + 16 * (lx & 15)), o); } }
        }
        asm volatile("s_waitcnt vmcnt(0)" ::: "memory");
        __syncthreads();
    }
#undef M2_STAGE
}

__device__ __forceinline__ void combine_phase(Frame& F) {
    const unsigned char* Y = (const unsigned char*)(F.ws + WS_Y); const int* TOKSLOT = (const int*)(F.ws + WS_TOKSLOT);
    const int gw = F.vcu * NWAVES + F.wave, NGW = F.G * NWAVES;
    f32x4 g4[4], b4[4];
#pragma unroll
    for (int j = 0; j < 4; ++j) { g4[j] = *(const GAS f32x4*)(F.ln2_g + 256 * j + 4 * F.lane); b4[j] = *(const GAS f32x4*)(F.ln2_b + 256 * j + 4 * F.lane); }
#pragma unroll 4
    for (int m = gw; m < T; m += NGW) {
        GAS f32x4* xr = (GAS f32x4*)(F.out + (size_t)m * D) + F.lane;
        unsigned yw[TOPK][4];
#pragma unroll
        for (int k = 0; k < TOPK; ++k) { const int slot = TOKSLOT[(size_t)m * 8 + k]; const GAS unsigned* yr = (const GAS unsigned*)(Y + (size_t)slot * D) + F.lane;
#pragma unroll
            for (int j = 0; j < 4; ++j) yw[k][j] = yr[64 * j]; }
        f32x4 v[4];
#pragma unroll
        for (int j = 0; j < 4; ++j) { const v2u pw = *(const GAS v2u*)((const GAS unsigned char*)(F.out + (size_t)m * D) + 512 * j + 8 * F.lane); v[j] = (f32x4){blo(pw.x), bhi(pw.x), blo(pw.y), bhi(pw.y)}; }
        f32x4 a[4];
#pragma unroll
        for (int j = 0; j < 4; ++j) a[j] = (f32x4){0.f, 0.f, 0.f, 0.f};
#pragma unroll
        for (int k = 0; k < TOPK; ++k)
#pragma unroll
            for (int j = 0; j < 4; ++j) { const f32x2 lo = __builtin_amdgcn_cvt_pk_f32_fp8((int)yw[k][j], false), hi = __builtin_amdgcn_cvt_pk_f32_fp8((int)yw[k][j], true);
                a[j].x += lo.x; a[j].y += lo.y; a[j].z += hi.x; a[j].w += hi.y; }
        float s = 0.f;
#pragma unroll
        for (int j = 0; j < 4; ++j) { v[j] = v[j] + a[j] * (1.0f / Y_SCALE); s += (v[j].x + v[j].y) + (v[j].z + v[j].w); }
        const float mean = wave_sum(s) * (1.f / D); float s2 = 0.f;
#pragma unroll
        for (int j = 0; j < 4; ++j) { v[j] = v[j] - mean; s2 += (v[j].x * v[j].x + v[j].y * v[j].y) + (v[j].z * v[j].z + v[j].w * v[j].w); }
        const float rstd = 1.f / sqrtf(wave_sum(s2) * (1.f / D) + LN_EPS);
#pragma unroll
#ifdef NT_OUT
        for (int j = 0; j < 4; ++j) __builtin_nontemporal_store(v[j] * rstd * g4[j] + b4[j], xr + 64 * j);
#else
        for (int j = 0; j < 4; ++j) xr[64 * j] = v[j] * rstd * g4[j] + b4[j];
#endif
    }
}
typedef float f32x16 __attribute__((ext_vector_type(16)));
typedef short s16x8 __attribute__((ext_vector_type(8)));
typedef short s16x4 __attribute__((ext_vector_type(4)));
constexpr int GQ_P = 272, GV_P = 144;
constexpr int G_QT = 0, G_KT = G_QT + 64 * GQ_P, G_KD = G_KT + 64 * GQ_P, G_VT = G_KD + 128 * GV_P, G_AM = G_VT + 256 * GV_P, G_SEG = G_AM + 64 * GV_P,
              G_DL = G_SEG + 8 * 128 * 4, G_WG = G_DL + 512, G_BG = G_WG + 128 * 16 * 4, G_GL = G_BG + 512, G_END = G_GL + 64 * 16 * 4, G_OB = G_QT, G_OBP = 260;
static_assert(G_END <= LDSCTL_OFF && 32 * G_OBP * 4 <= 2 * 64 * GQ_P, "GLA LDS map");
constexpr size_t TAB_DG = WS_TAB + 131072;

template <int MODE>
__device__ __forceinline__ void gla_units(Frame& F) {
    const bf16* QK = (const bf16*)(F.ws + WS_QK); const bf16* VB = (const bf16*)(F.ws + WS_V); const bf16* RB = (const bf16*)(F.ws + WS_R); bf16* OG = (bf16*)(F.ws + WS_OG);
    const float* GLR = (const float*)(F.ws + WS_GLR); float* LS = (float*)(F.ws + WS_L); float* DG = (float*)(F.ws + TAB_DG);
    LAS unsigned char* L = F.lds; bf16* GLG = (bf16*)F.out;
    const int lane = F.lane, w = F.wave, ig = w;
    const f32x4 gn = *(const GAS f32x4*)(F.gla_norm_g + 4 * lane);
#define GLA_LANE() int lx_ = lane; asm volatile("" : "+v"(lx_)); const int hh = lx_ >> 5, ln = lx_ & 31, d0 = 2 * lx_; (void)hh; (void)ln; (void)d0
    for (int u = F.vcu; u < 256; u += F.G) {
        const int b = u >> 7, h = (u >> 5) & 3, grp = u & 31; const size_t tok0 = (size_t)b * SEQ + (size_t)grp * 512;
        __syncthreads();
        if (MODE == 0 && F.tid < 128) { const int d = F.tid;
#pragma unroll
            for (int r = 0; r < GRANK; ++r) *(LAS float*)(L + G_WG + (r * 128 + d) * 4) = F.w_gate_up[r * 512 + h * 128 + d];
            *(LAS float*)(L + G_BG + d * 4) = F.b_gate[h * 128 + d]; }
        f32x16 S[4];
        if (MODE == 0) {
#pragma unroll
            for (int t = 0; t < 4; ++t)
#pragma unroll
                for (int r = 0; r < 16; ++r) S[t][r] = 0.f;
        } else {
#pragma unroll
            for (int t = 0; t < 4; ++t)
#pragma unroll
                for (int rp = 0; rp < 8; ++rp) { const unsigned wd = ((const unsigned*)LS)[(size_t)u * 16384 + ((w * 4 + t) * 8 + rp) * 64 + lane]; S[t][2 * rp] = blo(wd); S[t][2 * rp + 1] = bhi(wd); }
        }
        f32x2 gsum = (f32x2){0.f, 0.f};
        unsigned qraw[8], kraw[8], vraw[2][8], graw[8]; f32x2 glq = (f32x2){0.f, 0.f}; v2u rraw[2][4];
#define GLA_LOADR(c) do { const size_t t0_ = tok0 + 64 * (c); GLA_LANE(); _Pragma("unroll") for (int rt_ = 0; rt_ < 2; ++rt_) _Pragma("unroll") for (int q_ = 0; q_ < 4; ++q_) \
            rraw[rt_][q_] = *(const GAS v2u*)(RB + (t0_ + 32 * rt_ + 4 * w + q_) * 1024 + h * 256 + 4 * lx_); } while (0)
#define GLA_LOAD(c) do { const size_t t0_ = tok0 + 64 * (c); GLA_LANE(); const int tid_ = w * 64 + lx_; \
            _Pragma("unroll") for (int i = 0; i < 8; ++i) { const size_t tk = t0_ + 8 * ig + i; kraw[i] = *(const GAS unsigned*)(QK + tk * 1024 + 512 + h * 128 + d0); \
                if (MODE == 1) { qraw[i] = *(const GAS unsigned*)(QK + tk * 1024 + h * 128 + d0); graw[i] = *(const GAS unsigned*)(GLG + tk * 512 + h * 128 + d0); } } \
            if (MODE == 0) glq = *(const GAS f32x2*)(GLR + t0_ * GRANK + 2 * tid_); \
            _Pragma("unroll") for (int q = 0; q < 2; ++q) { const int id = tid_ + 512 * q, dvp = id & 127, tg = id >> 7; \
                _Pragma("unroll") for (int i = 0; i < 8; ++i) vraw[q][i] = *(const GAS unsigned*)(VB + (t0_ + 8 * tg + i) * 1024 + h * 256 + 2 * dvp); } } while (0)
        GLA_LOAD(0);
        if (MODE == 1) GLA_LOADR(0);
        if (MODE == 0) *(LAS f32x2*)(L + G_GL + F.tid * 8) = glq;
        __syncthreads();
        for (int c = 0; c < 8; ++c) {
            const size_t t0 = tok0 + 64 * c;
            f32x2 cs[8];
            {
                GLA_LANE();
                f32x2 run = (f32x2){0.f, 0.f};
                if (MODE == 0) {
                    f32x2 wg[GRANK];
#pragma unroll
                    for (int r = 0; r < GRANK; ++r) wg[r] = *(const LAS f32x2*)(L + G_WG + (r * 128 + d0) * 4);
                    const f32x2 bgv = *(const LAS f32x2*)(L + G_BG + d0 * 4);
#pragma unroll
                    for (int i = 0; i < 8; ++i) {
                        f32x2 z = bgv;
#pragma unroll
                        for (int q = 0; q < 4; ++q) { const f32x4 g4 = *(const LAS f32x4*)(L + G_GL + ((8 * ig + i) * 16 + 4 * q) * 4);
                            z += wg[4 * q] * g4.x; z += wg[4 * q + 1] * g4.y; z += wg[4 * q + 2] * g4.z; z += wg[4 * q + 3] * g4.w; }
                        const float l0 = (fminf(z.x, 0.f) - __logf(1.0f + __expf(-fabsf(z.x)))) * (1.0f / 16.0f), l1 = (fminf(z.y, 0.f) - __logf(1.0f + __expf(-fabsf(z.y)))) * (1.0f / 16.0f);
                        const unsigned gp = cvtpk(l0, l1);
                        *(GAS unsigned*)(GLG + (t0 + 8 * ig + i) * 512 + h * 128 + d0) = gp;
                        run += (f32x2){blo(gp), bhi(gp)}; cs[i] = run;
                    }
                } else {
#pragma unroll
                    for (int i = 0; i < 8; ++i) { run += (f32x2){blo(graw[i]), bhi(graw[i])}; cs[i] = run; }
                }
                *(LAS f32x2*)(L + G_SEG + (ig * 128 + d0) * 4) = run;
            }
            { GLA_LANE(); const int tid_ = w * 64 + lx_;
#pragma unroll
            for (int q = 0; q < 2; ++q) { const int id = tid_ + 512 * q, dvp = id & 127, tg = id >> 7;
                v4u lo, hi;
                lo.x = (vraw[q][0] & 0xffffu) | (vraw[q][1] << 16); lo.y = (vraw[q][2] & 0xffffu) | (vraw[q][3] << 16); lo.z = (vraw[q][4] & 0xffffu) | (vraw[q][5] << 16); lo.w = (vraw[q][6] & 0xffffu) | (vraw[q][7] << 16);
                hi.x = (vraw[q][0] >> 16) | (vraw[q][1] & 0xffff0000u); hi.y = (vraw[q][2] >> 16) | (vraw[q][3] & 0xffff0000u); hi.z = (vraw[q][4] >> 16) | (vraw[q][5] & 0xffff0000u); hi.w = (vraw[q][6] >> 16) | (vraw[q][7] & 0xffff0000u);
                *(LAS v4u*)(L + G_VT + (2 * dvp) * GV_P + tg * 16) = lo; *(LAS v4u*)(L + G_VT + (2 * dvp + 1) * GV_P + tg * 16) = hi; } }
            LDS_BARRIER();
            {
                GLA_LANE();
                f32x2 pre = (f32x2){0.f, 0.f}, tot = (f32x2){0.f, 0.f};
#pragma unroll
                for (int s = 0; s < 8; ++s) { const f32x2 sv = *(const LAS f32x2*)(L + G_SEG + (s * 128 + d0) * 4); tot += sv; if (s < ig) pre += sv; }
                const f32x2 dl = (f32x2){__expf(tot.x), __expf(tot.y)};
                if (ig == 0) *(LAS f32x2*)(L + G_DL + d0 * 4) = dl;
                gsum += tot;
                f32x2 kd[8];
#pragma unroll
                for (int i = 0; i < 8; ++i) {
                    const f32x2 bb = pre + cs[i];
                    const f32x2 kk = (f32x2){blo(kraw[i]), bhi(kraw[i])};
                    if (MODE == 1) {
                        const f32x2 kt = kk * (f32x2){__expf(-bb.x), __expf(-bb.y)};
                        const f32x2 qq = (f32x2){blo(qraw[i]), bhi(qraw[i])} * (f32x2){__expf(bb.x), __expf(bb.y)};
                        *(LAS unsigned*)(L + G_QT + (8 * ig + i) * GQ_P + d0 * 2) = cvtpk(qq.x, qq.y);
                        *(LAS unsigned*)(L + G_KT + (8 * ig + i) * GQ_P + d0 * 2) = cvtpk(kt.x, kt.y);
                        kd[i] = kt * dl;
                    } else { kd[i] = kk * (f32x2){__expf(tot.x - bb.x), __expf(tot.y - bb.y)}; }
                }
                v4u p0, p1;
                p0.x = cvtpk(kd[0].x, kd[1].x); p0.y = cvtpk(kd[2].x, kd[3].x); p0.z = cvtpk(kd[4].x, kd[5].x); p0.w = cvtpk(kd[6].x, kd[7].x);
                p1.x = cvtpk(kd[0].y, kd[1].y); p1.y = cvtpk(kd[2].y, kd[3].y); p1.z = cvtpk(kd[4].y, kd[5].y); p1.w = cvtpk(kd[6].y, kd[7].y);
                *(LAS v4u*)(L + G_KD + d0 * GV_P + ig * 16) = p0; *(LAS v4u*)(L + G_KD + (d0 + 1) * GV_P + ig * 16) = p1;
            }
            if (c < 7) GLA_LOAD(c + 1);
            LDS_BARRIER();
            f32x16 o[2];
            if (MODE == 1) {
                GLA_LANE();
#pragma unroll
                for (int tt = 0; tt < 2; ++tt) { const int id = 2 * w + tt, ti = id >> 2, tj = id & 3, r16 = lx_ & 15, kg = lx_ >> 4;
                    f32x4 sc = (f32x4){0.f, 0.f, 0.f, 0.f};
#pragma unroll
                    for (int ks = 0; ks < 4; ++ks) { const s16x8 ka = *(const LAS s16x8*)(L + G_KT + (16 * tj + r16) * GQ_P + (32 * ks + 8 * kg) * 2), qb = *(const LAS s16x8*)(L + G_QT + (16 * ti + r16) * GQ_P + (32 * ks + 8 * kg) * 2);
                        sc = __builtin_amdgcn_mfma_f32_16x16x32_bf16(ka, qb, sc, 0, 0, 0); }
                    const int i = 16 * ti + r16, j0 = 16 * tj + 4 * kg;
                    v2u pw; pw.x = cvtpk(j0 <= i ? sc[0] : 0.f, j0 + 1 <= i ? sc[1] : 0.f); pw.y = cvtpk(j0 + 2 <= i ? sc[2] : 0.f, j0 + 3 <= i ? sc[3] : 0.f);
                    *(LAS v2u*)(L + G_AM + i * GV_P + j0 * 2) = pw; }
                __builtin_amdgcn_sched_barrier(0);
#pragma unroll
                for (int rt = 0; rt < 2; ++rt)
#pragma unroll
                    for (int r = 0; r < 16; ++r) o[rt][r] = 0.f;
#pragma unroll
                for (int t = 0; t < 4; ++t)
#pragma unroll
                    for (int s = 0; s < 2; ++s) {
                        v4u pb; pb.x = cvtpk(S[t][8 * s], S[t][8 * s + 1]); pb.y = cvtpk(S[t][8 * s + 2], S[t][8 * s + 3]); pb.z = cvtpk(S[t][8 * s + 4], S[t][8 * s + 5]); pb.w = cvtpk(S[t][8 * s + 6], S[t][8 * s + 7]);
                        const s16x8 bfrag = __builtin_bit_cast(s16x8, pb);
#pragma unroll
                        for (int rt = 0; rt < 2; ++rt) { const int dk = 32 * t + 16 * s + 4 * hh;
                            const v2u a0 = *(const LAS v2u*)(L + G_QT + (32 * rt + ln) * GQ_P + dk * 2), a1 = *(const LAS v2u*)(L + G_QT + (32 * rt + ln) * GQ_P + (dk + 8) * 2);
                            const v4u av = (v4u){a0.x, a0.y, a1.x, a1.y};
                            o[rt] = __builtin_amdgcn_mfma_f32_32x32x16_bf16(__builtin_bit_cast(s16x8, av), bfrag, o[rt], 0, 0, 0); }
                        __builtin_amdgcn_sched_barrier(0);
                    }
                LDS_BARRIER();
            }
            {
                GLA_LANE();
                s16x8 vf[4];
#pragma unroll
                for (int s = 0; s < 4; ++s) vf[s] = *(const LAS s16x8*)(L + G_VT + (32 * w + ln) * GV_P + (16 * s + 8 * hh) * 2);
                if (MODE == 1) {
#pragma unroll
                    for (int s = 0; s < 4; ++s)
#pragma unroll
                        for (int rt = 0; rt < 2; ++rt) { if (rt == 0 && s >= 2) continue;
                            const s16x8 af = *(const LAS s16x8*)(L + G_AM + (32 * rt + ln) * GV_P + (16 * s + 8 * hh) * 2);
                            o[rt] = __builtin_amdgcn_mfma_f32_32x32x16_bf16(af, vf[s], o[rt], 0, 0, 0); }
                }
#pragma unroll
                for (int t = 0; t < 4; ++t) {
#pragma unroll
                    for (int g = 0; g < 4; ++g) { const f32x4 dv4 = *(const LAS f32x4*)(L + G_DL + (32 * t + 8 * g + 4 * hh) * 4);
                        S[t][4 * g] *= dv4.x; S[t][4 * g + 1] *= dv4.y; S[t][4 * g + 2] *= dv4.z; S[t][4 * g + 3] *= dv4.w; }
#pragma unroll
                    for (int s = 0; s < 4; ++s) { const s16x8 af = *(const LAS s16x8*)(L + G_KD + (32 * t + ln) * GV_P + (16 * s + 8 * hh) * 2);
                        S[t] = __builtin_amdgcn_mfma_f32_32x32x16_bf16(af, vf[s], S[t], 0, 0, 0); }
                    __builtin_amdgcn_sched_barrier(0);
                }
            }
            if (MODE == 0) { if (c < 7) *(LAS f32x2*)(L + G_GL + F.tid * 8) = glq; LDS_BARRIER(); }
            else {
#pragma unroll
                for (int rt = 0; rt < 2; ++rt) {
                    GLA_LANE();
                    if (rt == 1) LDS_BARRIER();
#pragma unroll
                    for (int r = 0; r < 16; ++r) *(LAS float*)(L + G_OB + (((r & 3) + 8 * (r >> 2) + 4 * hh) * G_OBP + 32 * w + ln) * 4) = o[rt][r];
                    LDS_BARRIER();
#pragma unroll
                    for (int q = 0; q < 4; ++q) { const int tl = 4 * w + q;
                        const f32x4 ov = *(const LAS f32x4*)(L + G_OB + (tl * G_OBP + 4 * lx_) * 4);
                        const float ss = wave_sum(ov.x * ov.x + ov.y * ov.y + ov.z * ov.z + ov.w * ov.w), rinv = __builtin_amdgcn_rsqf(ss * (1.0f / 256.0f) + RMS_EPS);
                        const float r0 = blo(rraw[rt][q].x), r1 = bhi(rraw[rt][q].x), r2 = blo(rraw[rt][q].y), r3 = bhi(rraw[rt][q].y);
                        v2u ow; ow.x = cvtpk(ov.x * rinv * gn.x * (r0 * pg8::sigm(r0)), ov.y * rinv * gn.y * (r1 * pg8::sigm(r1))); ow.y = cvtpk(ov.z * rinv * gn.z * (r2 * pg8::sigm(r2)), ov.w * rinv * gn.w * (r3 * pg8::sigm(r3)));
#ifdef NT_MISC
                        __builtin_nontemporal_store(ow, (GAS v2u*)(OG + (t0 + 32 * rt + tl) * 1024 + h * 256 + 4 * lx_)); }
#else
                        *(GAS v2u*)(OG + (t0 + 32 * rt + tl) * 1024 + h * 256 + 4 * lx_) = ow; }
#endif
                }
                if (c < 7) GLA_LOADR(c + 1);
            }
        }
#undef GLA_LOAD
#undef GLA_LOADR
        if (MODE == 0) {
#pragma unroll
            for (int t = 0; t < 4; ++t)
#pragma unroll
                for (int rp = 0; rp < 8; ++rp) ((unsigned*)LS)[(size_t)u * 16384 + ((w * 4 + t) * 8 + rp) * 64 + lane] = cvtpk(S[t][2 * rp], S[t][2 * rp + 1]);
            if (ig == 0) *(GAS f32x2*)(DG + (size_t)u * 128 + 2 * lane) = (f32x2){__expf(gsum.x), __expf(gsum.y)};
        }
    }
}
#undef GLA_LANE
__device__ __forceinline__ void gla_scan_phase(Frame& F) {
    unsigned* LSW = (unsigned*)(F.ws + WS_L); const float* DG = (const float*)(F.ws + TAB_DG);
    const int gt = F.vcu * (NWAVES * 64) + F.tid, NT = F.G * NWAVES * 64;
    for (int idx = gt; idx < 8 * 16384; idx += NT) {
        const int bh = idx >> 14, e = idx & 16383, l = e & 63, rp = (e >> 6) & 7, t = (e >> 9) & 3, r0 = 2 * rp, dk = 32 * t + (r0 & 3) + 8 * (r0 >> 2) + 4 * (l >> 5);
        float s0 = 0.f, s1 = 0.f;
#pragma unroll 8
        for (int j = 0; j < 32; ++j) { const size_t a = (size_t)(bh * 32 + j) * 16384 + e; const unsigned lv = LSW[a]; LSW[a] = cvtpk(s0, s1);
            const f32x2 dg = *(const f32x2*)(DG + (bh * 32 + j) * 128 + dk); s0 = dg.x * s0 + blo(lv); s1 = dg.y * s1 + bhi(lv); }
    }
}
constexpr int NPH = 12;
struct Args { const float* in[22]; float* out; unsigned char* ws; int ph_lo, ph_hi, li, pad; };
__global__ void __launch_bounds__(NWAVES * 64, 2) fwd(Args args) {
    extern __shared__ __attribute__((aligned(16))) unsigned char lds[];
    Frame F;
    F.lds = (LAS unsigned char*)lds;
    F.MISC = (volatile LAS unsigned*)(F.lds + MISC_OFF);
    F.tid = threadIdx.x; F.lane = F.tid & 63; F.wave = __builtin_amdgcn_readfirstlane(F.tid >> 6);
    F.G = gridDim.x; { const int bx = blockIdx.x; F.vcu = (F.G % 8 == 0) ? (bx % 8) * (F.G / 8) + bx / 8 : bx; }
    F.ws = args.ws; F.ctl = (gu32*)(args.ws + WS_CTL); F.out = args.out;
    F.x = args.in[0]; F.w_in = args.in[1]; F.w_gate_up = args.in[2]; F.b_gate = args.in[3]; F.gla_norm_g = args.in[4]; F.w_gla_up = args.in[5]; F.w_pool_grp = args.in[6];
    F.pool_scale = args.in[7]; F.w_pool_up = args.in[8]; F.w_out = args.in[9]; F.ln1_g = args.in[10]; F.ln1_b = args.in[11]; F.w_router = args.in[12]; F.router_bias = args.in[13];
    F.w_exp_gate = args.in[14]; F.w_exp_up = args.in[15]; F.w_exp_down = args.in[16]; F.w_sh_gate = args.in[17]; F.w_sh_up = args.in[18]; F.w_sh_down = args.in[19]; F.ln2_g = args.in[20]; F.ln2_b = args.in[21];
    for (int u = F.tid; u < (LDS_BYTES - LDSCTL_OFF) / 4; u += NWAVES * 64) ((LAS unsigned*)(F.lds + LDSCTL_OFF))[u] = 0u;
    __syncthreads();
    XcdBarrier bar; bar.bar = (unsigned*)(F.ctl + CW_BAR); bar.x = 0; bar.st = nullptr;
    if (MK_FUSED) bar = xcd_barrier_post((unsigned*)(F.ctl + CW_BAR), F.MISC + 8);
#define GRID_BAR() do { if (MK_FUSED) xcd_barrier(bar); } while (0)
    const int lo = args.ph_lo, hi = args.ph_hi;
#ifdef PHASE_ONLY
#define IN(k) ((k) == PHASE_ONLY && lo <= (k) && (k) < hi)
#else
#define IN(k) (lo <= (k) && (k) < hi)
#endif
#define BOTH(k) (IN(k) && IN((k) + 1))
    const PG8_LAS int* idxtab = (const PG8_LAS int*)(F.lds + IDX_OFF);
    bf16* const QK = (bf16*)(F.ws + WS_QK); bf16* const VB = (bf16*)(F.ws + WS_V); bf16* const RB = (bf16*)(F.ws + WS_R); bf16* const UB = (bf16*)(F.ws + WS_U);
    bf16* const GA = (bf16*)(F.ws + WS_GA); bf16* const GB = (bf16*)(F.ws + WS_GB);

    if (IN(0)) { p0_prologue(F); if (BOTH(0)) GRID_BAR(); }
    if (IN(1)) { {
        pg8::StaticOrder S; S.init(T, NPROJ, F.G, (int)blockIdx.x);
        pg8::EpiProj E{QK, VB, RB, UB, GA, GB};
        pg8::gemm_phase<pg8::EpiProj, pg8::StaticOrder, PG8_ALIGN, PG8_SP2, false>(F.lds + RING_OFF, (const bf16*)(F.ws + WS_XB), (const bf16*)(F.ws + WS_WIN), D, S, E, idxtab); }
        if (BOTH(1)) GRID_BAR();
    }
    if (IN(2)) { pool_phase(F); gla_units<0>(F); if (BOTH(2)) GRID_BAR(); }
    if (IN(3)) { gla_scan_phase(F); if (BOTH(3)) GRID_BAR(); }
    if (IN(4)) { gla_units<1>(F); if (BOTH(4)) GRID_BAR(); }
    if (IN(5)) { {
        pg8::StaticOrder S; S.init(T, D, F.G, (int)blockIdx.x);
        { pg8::EpiGate<0> E{GA, nullptr, (bf16*)(F.ws + WS_T1)};
          pg8::gemm_phase<pg8::EpiGate<0>, pg8::StaticOrder, PG8_ALIGN, PG8_SP2, false>(F.lds + RING_OFF, (const bf16*)(F.ws + WS_OG), (const bf16*)(F.ws + WS_WGLA), D, S, E, idxtab); }
        { pg8::EpiGate<1> E{GB, (const bf16*)(F.ws + WS_T1), (bf16*)(F.ws + WS_MG)};
          pg8::gemm_phase<pg8::EpiGate<1>, pg8::StaticOrder, PG8_ALIGN, PG8_SP2, false>(F.lds + RING_OFF, (const bf16*)(F.ws + WS_PO), (const bf16*)(F.ws + WS_WPC), PW, S, E, idxtab); } }
        if (BOTH(5)) GRID_BAR();
    }
    if (IN(6)) { {
        pg8::StaticOrder S; S.init(T, D, F.G, (int)blockIdx.x);
        pg8::EpiPre1 E{F.x, (bf16*)F.out, DN_ALPHA, (float*)(F.ws + WS_PST)};
        pg8::gemm_phase<pg8::EpiPre1, pg8::StaticOrder, PG8_ALIGN, PG8_SP2, false>(F.lds + RING_OFF, (const bf16*)(F.ws + WS_MG), (const bf16*)(F.ws + WS_WOUT), D, S, E, idxtab); }
        if (BOTH(6)) GRID_BAR();
    }
    if (IN(7)) { router_phase(F); expert_w1_phase(F); if (BOTH(7)) GRID_BAR(); }
    if (IN(8)) { assign_phase(F); if (BOTH(8)) GRID_BAR(); }
    const int* TILEE = (const int*)(F.ws + TAB_TILEE); const int* META = (const int*)(F.ws + TAB_META);
    if (IN(9)) { {
        Moe1Order S{TILEE, META[MT_NT], F.G, (int)blockIdx.x};
        { const int* ROWTOK = (const int*)(F.ws + WS_ROWTOK); LAS int* it = (LAS int*)(F.lds + IDX_OFF);
          int rowv[IDX_UNITS];
#pragma unroll
          for (int i = 0; i < IDX_UNITS; ++i) { const int rt = S.row_tile(i); rowv[i] = (rt >= 0 && F.tid < 256) ? ROWTOK[rt * 256 + F.tid] : 0; }
#pragma unroll
          for (int i = 0; i < IDX_UNITS; ++i) if (F.tid < 256) it[i * 256 + F.tid] = rowv[i];
          __syncthreads(); }
        pg8::EpiMoe1F8 E{F.ws + WS_H, (const float*)(F.ws + WS_ROWW)};
        pg8::gemm_phase<pg8::EpiMoe1F8, Moe1Order, PG8_ALIGN, PG8_SP2, true, true, -5>(F.lds + RING_OFF, (const bf16*)(F.ws + WS_H1F), (const bf16*)(F.ws + WS_W1), D / 2, S, E, idxtab); }
        expert_w2_phase(F);
        if (BOTH(9)) GRID_BAR();
    }
    if (IN(10)) {
        { pg8::StaticOrder S; S.init(T, D, F.G, (int)blockIdx.x);
          pg8::EpiPre2 E{(bf16*)F.out, (const float*)(F.ws + TAB_STATS), F.ln1_g, F.ln1_b, DN_ALPHA, 1.0f};
          pg8::gemm_phase<pg8::EpiPre2, pg8::StaticOrder, PG8_ALIGN, PG8_SP2, false, true, -9>(F.lds + RING_OFF, (const bf16*)(F.ws + WS_H + (size_t)ROUTED_TILES * 256 * FF), (const bf16*)(F.ws + WS_W2 + (size_t)NE * D * FF), FF / 2, S, E, idxtab); }
#ifdef MOE2_PG8
        { Moe2Order S{TILEE, META[MT_NT], F.G, (int)blockIdx.x};
          pg8::EpiFp8 E{(unsigned char*)(F.ws + WS_Y), D, 1.0f};
          pg8::gemm_phase<pg8::EpiFp8, Moe2Order, PG8_ALIGN, PG8_SP2, false, true, -5>(F.lds + RING_OFF, (const bf16*)(F.ws + WS_H), (const bf16*)(F.ws + WS_W2), FF / 2, S, E, idxtab); }
#else
        moe2_stationary_phase(F);
#ifdef M2_PROBE
        moe2_stationary_phase<M2_PROBE>(F);
#endif
#endif
        if (BOTH(10)) GRID_BAR();
    }
    if (IN(11)) { combine_phase(F); }
#undef IN
#undef BOTH
}

extern "C" void kernel_launch(void* const* d_in, const int* in_sizes, int n_in, void* d_out, int out_size, void* d_ws, size_t ws_size, hipStream_t stream) {
    static int grid = 0;
    if (grid == 0) {
        if (n_in != 22 || in_sizes[0] != T * D || out_size != T * D || ws_size < WS_END) { fprintf(stderr, "kernel_launch: built for 22 inputs, x/out of %d floats, >= %zu bytes of workspace; got n_in %d, in0 %d, out %d, ws %zu; nothing launched\n", T * D, (size_t)WS_END, n_in, n_in > 0 ? in_sizes[0] : -1, out_size, ws_size); grid = -1; return; }
        int dev = 0, cus = 0, per_cu = 0;
        if (hipGetDevice(&dev) != hipSuccess || hipDeviceGetAttribute(&cus, hipDeviceAttributeMultiprocessorCount, dev) != hipSuccess) { fprintf(stderr, "kernel_launch: device query failed\n"); grid = -1; return; }
        if (hipFuncSetAttribute((const void*)fwd, hipFuncAttributeMaxDynamicSharedMemorySize, LDS_BYTES) != hipSuccess) { fprintf(stderr, "kernel_launch: hipFuncSetAttribute failed\n"); grid = -1; return; }
        if (hipOccupancyMaxActiveBlocksPerMultiprocessor(&per_cu, (const void*)fwd, NWAVES * 64, LDS_BYTES) != hipSuccess || per_cu < 1)
            fprintf(stderr, "kernel_launch: note: occupancy query reports %d workgroups per CU\n", per_cu);
        (void)hipGetLastError();
        grid = cus;
        if (grid > 256) grid = 256;
    }
    if (grid < 0) return;
    if (hipMemsetAsync((char*)d_ws + WS_CTL, 0, CTL_ZERO_BYTES, stream) != hipSuccess) { fprintf(stderr, "kernel_launch: memset failed\n"); return; }
    Args a{};
    for (int i = 0; i < 22; ++i) a.in[i] = (const float*)d_in[i];
    a.out = (float*)d_out; a.ws = (unsigned char*)d_ws;
#if MK_FUSED
    a.ph_lo = 0; a.ph_hi = NPH; a.li = 0;
    hipLaunchKernelGGL(fwd, dim3(grid), dim3(NWAVES * 64), LDS_BYTES, stream, a);
#else
    for (int li = 0; li < NPH; ++li) { a.ph_lo = li; a.ph_hi = li + 1; a.li = li; hipLaunchKernelGGL(fwd, dim3(grid), dim3(NWAVES * 64), LDS_BYTES, stream, a); }
#endif
    const hipError_t le = hipPeekAtLastError();
    if (le != hipSuccess) fprintf(stderr, "kernel_launch: launch failed: %s\n", hipGetErrorName(le));
}
```

```cpp
#include <hip/hip_runtime.h>
#include <cstdio>
#include <cstdint>
#include <cmath>
#define MK_FUSED 1
#define NT_LOADS 1
namespace pg8 {
#define PG8_LAS __attribute__((address_space(3)))
typedef unsigned short bf16_t;
typedef short bf16x8 __attribute__((ext_vector_type(8)));
typedef float f32x4 __attribute__((ext_vector_type(4)));
typedef float f32x2 __attribute__((ext_vector_type(2)));
typedef unsigned u32x4 __attribute__((ext_vector_type(4)));
typedef unsigned u32x2 __attribute__((ext_vector_type(2)));
typedef int i32x4 __attribute__((ext_vector_type(4)));
typedef int i32x8 __attribute__((ext_vector_type(8)));
constexpr int BM = 256, BK = 64, HALF = 128, HTB = HALF * BK * 2  , STAGE_BYTES = 8 * HTB, NXCD = 8, WGM = 4;

__host__ __device__ __forceinline__ int lds_byte(int r, int c) { const int st = (r >> 4) * 2 + (c >> 5), rr = r & 15, cc = c & 31, ob = rr * 64 + cc * 2; return st * 1024 + (ob ^ (((ob >> 9) & 1) << 5)); }
__host__ __device__ __forceinline__ void stage_rc(int b, int& R, int& C) { const int st = b / 1024, sb = b % 1024, swz = sb ^ (((sb >> 9) & 1) << 5); R = (st >> 1) * 16 + swz / 64; C = (st & 1) * 32 + (swz % 64) / 2; }
__host__ __device__ __forceinline__ int perm32(int rho) { const int n = rho >> 4, i = rho & 15; return 8 * (i >> 2) + 4 * n + (i & 3); }

struct Unit { int pm, pn, at, bt; };

__host__ __device__ __forceinline__ int xcd_remap(int wgid, int nwg) { const int q = nwg / NXCD, r = nwg % NXCD, xcd = wgid % NXCD, off = wgid / NXCD; return (xcd < r ? xcd * (q + 1) : r * (q + 1) + (xcd - r) * q) + off; }

struct StaticOrder {
    int nM, nN, nwg, G, c;
    __host__ __device__ void init(int M, int N, int G_, int c_) { nM = M / BM; nN = N / BM; nwg = nM * nN; G = G_; c = c_; }
    __host__ __device__ bool next(int i, Unit& u) const {
        const long L = (long)i * G + c; if (L >= nwg) return false;
        const int wgid = xcd_remap((int)L, nwg);
        const int nig = WGM * nN, gid = wgid / nig, fm = gid * WGM, gsz = (nM - fm) < WGM ? (nM - fm) : WGM;
        u.pm = fm + ((wgid % nig) % gsz); u.pn = (wgid % nig) / gsz; u.at = u.pm; u.bt = u.pn; return true;
    }
};

__device__ __forceinline__ unsigned cvt_pk_bf16(float lo, float hi) { unsigned r; asm volatile("v_cvt_pk_bf16_f32 %0, %1, %2" : "=v"(r) : "v"(lo), "v"(hi)); return r; }
__device__ __forceinline__ float bflo(unsigned w) { return __uint_as_float(w << 16); }
__device__ __forceinline__ float bfhi(unsigned w) { return __uint_as_float(w & 0xffff0000u); }
__device__ __forceinline__ float sigm(float x) { return __builtin_amdgcn_rcpf(1.0f + __expf(-x)); }
__device__ __forceinline__ u32x4 pack8(const f32x4& v0, const f32x4& v1) { u32x4 w; w.x = cvt_pk_bf16(v0[0], v0[1]); w.y = cvt_pk_bf16(v0[2], v0[3]); w.z = cvt_pk_bf16(v1[0], v1[1]); w.w = cvt_pk_bf16(v1[2], v1[3]); return w; }
__device__ __forceinline__ void unpack8(const u32x4& w, f32x4& v0, f32x4& v1) { v0 = (f32x4){bflo(w.x), bfhi(w.x), bflo(w.y), bfhi(w.y)}; v1 = (f32x4){bflo(w.z), bfhi(w.z), bflo(w.w), bfhi(w.w)}; }

struct EpiBf16 {
    static constexpr bool PERM = true;
    bf16_t* O; int ldc;
    __device__ __forceinline__ void operator()(const f32x4 (&acc)[2][2][4][2], const Unit& u, int wr, int wc, int fr, int fq) const {
        const int row0 = u.pm * BM + wr * 64 + fr, col0 = u.pn * BM + wc * 32 + 8 * fq;
#pragma unroll
        for (int ai = 0; ai < 2; ++ai)
#pragma unroll
            for (int m = 0; m < 4; ++m) { bf16_t* rowp = O + (size_t)(row0 + ai * HALF + m * 16) * ldc + col0;
#pragma unroll
                for (int bj = 0; bj < 2; ++bj) *(u32x4*)(rowp + bj * HALF) = pack8(acc[ai][bj][m][0], acc[ai][bj][m][1]); }
    }
};
__device__ __forceinline__ unsigned pk4_fp8(float a, float b, float c, float d) {
    int p = 0; p = __builtin_amdgcn_cvt_pk_fp8_f32(__builtin_amdgcn_fmed3f(a, -440.f, 440.f), __builtin_amdgcn_fmed3f(b, -440.f, 440.f), p, false);
    p = __builtin_amdgcn_cvt_pk_fp8_f32(__builtin_amdgcn_fmed3f(c, -440.f, 440.f), __builtin_amdgcn_fmed3f(d, -440.f, 440.f), p, true); return (unsigned)p; }
struct EpiMoe1F8 {
    static constexpr bool PERM = true;
    unsigned char* H; const float* RW;
    __device__ __forceinline__ void operator()(const f32x4 (&acc)[2][2][4][2], const Unit& u, int wr, int wc, int fr, int fq) const {
        const int row0 = u.pm * BM + wr * 64 + fr, col0 = u.pn * HALF + wc * 32 + 8 * fq;
#pragma unroll
        for (int ai = 0; ai < 2; ++ai)
#pragma unroll
            for (int m = 0; m < 4; ++m) { const int row = row0 + ai * HALF + m * 16; const float w = RW[row] * 16.0f;
                float v[8];
#pragma unroll
                for (int j = 0; j < 4; ++j) { const float g0 = acc[ai][0][m][0][j], g1 = acc[ai][0][m][1][j];
                    v[j] = g0 * sigm(g0) * acc[ai][1][m][0][j] * w; v[4 + j] = g1 * sigm(g1) * acc[ai][1][m][1][j] * w; }
                *(u32x2*)(H + (size_t)row * 256 + col0) = (u32x2){pk4_fp8(v[0], v[1], v[2], v[3]), pk4_fp8(v[4], v[5], v[6], v[7])}; }
    }
};
struct EpiFp8 {
    static constexpr int PERM = 2;
    unsigned char* O; int ldc; float scale;
    __device__ __forceinline__ void operator()(const f32x4 (&acc)[2][2][4][2], const Unit& u, int wr, int wc, int fr, int fq) const {
        const int row0 = u.pm * BM + wr * 64 + fr, col0 = u.pn * BM + wc * 64 + 16 * fq;
#pragma unroll
        for (int ai = 0; ai < 2; ++ai)
#pragma unroll
            for (int m = 0; m < 4; ++m) { unsigned char* rowp = O + (size_t)(row0 + ai * HALF + m * 16) * ldc + col0; u32x4 w;
#pragma unroll
                for (int bj = 0; bj < 2; ++bj)
#pragma unroll
                    for (int n = 0; n < 2; ++n) { const f32x4 v = (scale == 1.0f) ? acc[ai][bj][m][n] : acc[ai][bj][m][n] * scale; int p = 0;
                        p = __builtin_amdgcn_cvt_pk_fp8_f32(v[0], v[1], p, false); p = __builtin_amdgcn_cvt_pk_fp8_f32(v[2], v[3], p, true); w[bj * 2 + n] = (unsigned)p; }
                *(u32x4*)rowp = w; }
    }
};
struct EpiProj {
    static constexpr bool PERM = true;
    bf16_t *QK, *V, *R, *U, *GA, *GB;
    __device__ __forceinline__ void operator()(const f32x4 (&acc)[2][2][4][2], const Unit& u, int wr, int wc, int fr, int fq) const {
        const int pn = u.pn; bf16_t* base; int ldc = 1024, ct;
        if (pn < 4) { base = QK; ct = pn; } else if (pn < 8) { base = V; ct = pn - 4; } else if (pn < 12) { base = R; ct = pn - 8; }
        else if (pn < 14) { base = U; ct = pn - 12; ldc = 512; } else if (pn < 18) { base = GA; ct = pn - 14; } else { base = GB; ct = pn - 18; }
        const int row0 = u.pm * BM + wr * 64 + fr, col0 = ct * BM + wc * 32 + 8 * fq;
#pragma unroll
        for (int ai = 0; ai < 2; ++ai)
#pragma unroll
            for (int m = 0; m < 4; ++m) { bf16_t* rowp = base + (size_t)(row0 + ai * HALF + m * 16) * ldc + col0;
#pragma unroll
                for (int bj = 0; bj < 2; ++bj) *(u32x4*)(rowp + bj * HALF) = pack8(acc[ai][bj][m][0], acc[ai][bj][m][1]); }
    }
};
template <int MODE> struct EpiGate {
    static constexpr bool PERM = true;
    const bf16_t* G; const bf16_t* P; bf16_t* O;
    __device__ __forceinline__ void operator()(const f32x4 (&acc)[2][2][4][2], const Unit& u, int wr, int wc, int fr, int fq) const {
        const int row0 = u.pm * BM + wr * 64 + fr, col0 = u.pn * BM + wc * 32 + 8 * fq;
#pragma unroll
        for (int ai = 0; ai < 2; ++ai)
#pragma unroll
            for (int m = 0; m < 4; ++m) { const size_t off = (size_t)(row0 + ai * HALF + m * 16) * 1024 + col0;
#pragma unroll
                for (int bj = 0; bj < 2; ++bj) {
                    const u32x4 gw = *(const u32x4*)(G + off + bj * HALF); f32x4 g0, g1; unpack8(gw, g0, g1);
                    f32x4 v0 = acc[ai][bj][m][0], v1 = acc[ai][bj][m][1];
#pragma unroll
                    for (int j = 0; j < 4; ++j) { v0[j] *= sigm(g0[j]); v1[j] *= sigm(g1[j]); }
                    if (MODE == 1) { const u32x4 pw = *(const u32x4*)(P + off + bj * HALF); f32x4 p0, p1; unpack8(pw, p0, p1); v0 += p0; v1 += p1; }
                    *(u32x4*)(O + off + bj * HALF) = pack8(v0, v1); } }
    }
};
struct EpiPre1 {
    static constexpr bool PERM = true;
    const float* X; bf16_t* O; float alpha; float* PST;
    __device__ __forceinline__ void operator()(const f32x4 (&acc)[2][2][4][2], const Unit& u, int wr, int wc, int fr, int fq) const {
        const int row0 = u.pm * BM + wr * 64 + fr, col0 = u.pn * BM + wc * 32 + 8 * fq;
#pragma unroll
        for (int ai = 0; ai < 2; ++ai)
#pragma unroll
            for (int m = 0; m < 4; ++m) { const int row = row0 + ai * HALF + m * 16; float s = 0.f, q = 0.f;
#pragma unroll
                for (int bj = 0; bj < 2; ++bj) { const float* xp = X + (size_t)row * 1024 + col0 + bj * HALF;
                    const f32x4 p0 = *(const f32x4*)xp * alpha + acc[ai][bj][m][0], p1 = *(const f32x4*)(xp + 4) * alpha + acc[ai][bj][m][1];
                    *(u32x4*)(O + (size_t)row * 2048 + col0 + bj * HALF) = pack8(p0, p1);
                    s += ((p0[0] + p0[1]) + (p0[2] + p0[3])) + ((p1[0] + p1[1]) + (p1[2] + p1[3]));
                    q += ((p0[0] * p0[0] + p0[1] * p0[1]) + (p0[2] * p0[2] + p0[3] * p0[3])) + ((p1[0] * p1[0] + p1[1] * p1[1]) + (p1[2] * p1[2] + p1[3] * p1[3])); }
                { auto a = __builtin_amdgcn_permlane16_swap(__float_as_uint(s), __float_as_uint(s), false, false); s = __uint_as_float(a[0]) + __uint_as_float(a[1]);
                  auto b = __builtin_amdgcn_permlane32_swap(__float_as_uint(s), __float_as_uint(s), false, false); s = __uint_as_float(b[0]) + __uint_as_float(b[1]);
                  auto c = __builtin_amdgcn_permlane16_swap(__float_as_uint(q), __float_as_uint(q), false, false); q = __uint_as_float(c[0]) + __uint_as_float(c[1]);
                  auto d = __builtin_amdgcn_permlane32_swap(__float_as_uint(q), __float_as_uint(q), false, false); q = __uint_as_float(d[0]) + __uint_as_float(d[1]); }
                if (fq == 0) *(f32x2*)(PST + ((size_t)row * 16 + u.pn * 4 + wc) * 2) = (f32x2){s, q}; }
    }
};
struct EpiPre2 {
    static constexpr bool PERM = true;
    bf16_t* IO; const float* ST; const float* g; const float* b; float alpha; float ascale;
    __device__ __forceinline__ void operator()(f32x4 (&acc)[2][2][4][2], const Unit& u, int wr, int wc, int fr, int fq) const {
        const unsigned row0 = (unsigned)(u.pm * BM + wr * 64 + fr), col0 = (unsigned)(u.pn * BM + wc * 32 + 8 * fq);
        const unsigned char* STb = (const unsigned char*)ST; unsigned char* IOb = (unsigned char*)IO;
#pragma unroll
        for (int bj = 0; bj < 2; ++bj) { const f32x4 g0 = *(const f32x4*)(g + col0 + bj * HALF), g1 = *(const f32x4*)(g + col0 + bj * HALF + 4), b0 = *(const f32x4*)(b + col0 + bj * HALF), b1 = *(const f32x4*)(b + col0 + bj * HALF + 4);
#pragma unroll
            for (int ai = 0; ai < 2; ++ai)
#pragma unroll
                for (int m = 0; m < 4; ++m) { const unsigned row = row0 + (unsigned)(ai * HALF + m * 16); const f32x2 st = *(const f32x2*)(STb + row * 8u);
                    u32x4* pp = (u32x4*)(IOb + (row * 2048u + col0 + (unsigned)(bj * HALF)) * 2u); f32x4 p0, p1; unpack8(*pp, p0, p1);
                    const f32x4 r0 = acc[ai][bj][m][0] * ascale + ((p0 - st.x) * st.y * g0 + b0) * alpha, r1 = acc[ai][bj][m][1] * ascale + ((p1 - st.x) * st.y * g1 + b1) * alpha;
                    *pp = pack8(r0, r1); }
            asm volatile("" ::: "memory"); }
    }
};
struct EpiMoe1 {
    static constexpr bool PERM = true;
    bf16_t* H; const float* RW;
    __device__ __forceinline__ void operator()(const f32x4 (&acc)[2][2][4][2], const Unit& u, int wr, int wc, int fr, int fq) const {
        const int row0 = u.pm * BM + wr * 64 + fr, col0 = u.pn * HALF + wc * 32 + 8 * fq;
#pragma unroll
        for (int ai = 0; ai < 2; ++ai)
#pragma unroll
            for (int m = 0; m < 4; ++m) { const int row = row0 + ai * HALF + m * 16; const float w = RW[row];
                f32x4 v0, v1;
#pragma unroll
                for (int j = 0; j < 4; ++j) { const float g0 = acc[ai][0][m][0][j], g1 = acc[ai][0][m][1][j];
                    v0[j] = g0 * sigm(g0) * acc[ai][1][m][0][j] * w; v1[j] = g1 * sigm(g1) * acc[ai][1][m][1][j] * w; }
                *(u32x4*)(H + (size_t)row * 256 + col0) = pack8(v0, v1); }
    }
};

template <class Epi, class Sched, bool ALIGN_EPI, bool SP2, bool GATHER, bool FP8 = false, int F8SHIFT = 0>
__device__ __forceinline__ void gemm_phase(PG8_LAS unsigned char* lds, const bf16_t* Aop, const bf16_t* Bop, const int K_, const Sched& S, const Epi& E, const PG8_LAS int* idxtab) {
    int K = K_; asm volatile("" : "+s"(K));
    int tid_ = threadIdx.x; asm volatile("" : "+v"(tid_));
    const int tid = tid_, wid = __builtin_amdgcn_readfirstlane(tid >> 6), lane = tid & 63, wr = wid >> 2, wc = wid & 3, fr = lane & 15, fq = lane >> 4;
    const int nt = K / BK;
    unsigned voffA[2], voffB[2]; int RA[2], CA[2];
#pragma unroll
    for (int i = 0; i < 2; ++i) { int R, C; stage_rc(tid * 16 + i * 8192, R, C);
        const int Rb = (int)Epi::PERM == 2 ? (64 * (R >> 5) + 16 * ((R >> 2) & 3) + 4 * ((R >> 4) & 1) + (R & 3)) : (int)Epi::PERM == 1 ? ((R & ~31) + perm32(R & 31)) : R;
        voffA[i] = (unsigned)(R * K + C) * 2u; voffB[i] = (unsigned)(Rb * K + C) * 2u; RA[i] = R; CA[i] = C; }
    const size_t kstep = (size_t)(BK * 2);
    const size_t hstep = (size_t)HALF * K * 2;
    const size_t tstep = 2 * hstep;
    const size_t bh1 = (int)Epi::PERM == 2 ? (size_t)16 * K : hstep;
    const unsigned ldsw = (unsigned)wid * 1024u;
    const int aoff = lds_byte(wr * 64 + fr, fq * 8), boff = lds_byte(wc * 32 + fr, fq * 8);
    unsigned vAc[2][2], vAn[2][2];
#define PG8_GIDX(dst, ord) do { _Pragma("unroll") for (int _h = 0; _h < 2; ++_h) _Pragma("unroll") for (int _i = 0; _i < 2; ++_i) \
        dst[_h][_i] = (unsigned)(idxtab[(ord) * 256 + _h * HALF + RA[_i]] * K + CA[_i]) * 2u; } while (0)
#define PG8_SA(b, h) (((b) * 2 + (h)) * HTB)
#define PG8_SB(b, h) ((4 + (b) * 2 + (h)) * HTB)
#define PG8_STAGE(bufoff, gbase, voff) do { _Pragma("unroll") for (int _i = 0; _i < 2; ++_i) \
        __builtin_amdgcn_global_load_lds((const unsigned*)((const char*)(gbase) + (voff)[_i]), (PG8_LAS unsigned*)(lds + (bufoff) + ldsw + _i * 8192), 16, 0, 0); } while (0)
#define PG8_STAGE_A(bufoff, kptr, h, nx) do { if constexpr (GATHER) { unsigned _v[2]; _v[0] = (nx) ? vAn[h][0] : vAc[h][0]; _v[1] = (nx) ? vAn[h][1] : vAc[h][1]; PG8_STAGE(bufoff, kptr, _v); } \
        else { PG8_STAGE(bufoff, (kptr) + (h) * hstep, voffA); } } while (0)
#define PG8_LD8(dst, off) do { const i32x4 lo_ = *(const PG8_LAS i32x4*)(lds + (off)), hi_ = *(const PG8_LAS i32x4*)(lds + (off) + 1024); dst = __builtin_shufflevector(lo_, hi_, 0, 1, 2, 3, 4, 5, 6, 7); } while (0)
#define PG8_LDA(dst, b, h) do { if constexpr (FP8) { _Pragma("unroll") for (int m = 0; m < 4; ++m) PG8_LD8(dst##8[m], PG8_SA(b, h) + aoff + m * 2048); } \
        else { _Pragma("unroll") for (int m = 0; m < 4; ++m) _Pragma("unroll") for (int k = 0; k < 2; ++k) dst[m][k] = *(const PG8_LAS bf16x8*)(lds + PG8_SA(b, h) + aoff + m * 2048 + k * 1024); } } while (0)
#define PG8_LDB(dst, b, h) do { if constexpr (FP8) { _Pragma("unroll") for (int n = 0; n < 2; ++n) PG8_LD8(dst##8[n], PG8_SB(b, h) + boff + n * 2048); } \
        else { _Pragma("unroll") for (int n = 0; n < 2; ++n) _Pragma("unroll") for (int k = 0; k < 2; ++k) dst[n][k] = *(const PG8_LAS bf16x8*)(lds + PG8_SB(b, h) + boff + n * 2048 + k * 1024); } } while (0)
#define PG8_MMA(ai, bj, At, Bt) do { __builtin_amdgcn_s_setprio(1); \
        if constexpr (FP8) { if (zc) { _Pragma("unroll") for (int m = 0; m < 4; ++m) _Pragma("unroll") for (int n = 0; n < 2; ++n) \
                asm volatile("v_mfma_scale_f32_16x16x128_f8f6f4 %0, %1, %2, 0, %3, %4 op_sel_hi:[0,0,0]" : "=&v"(acc[ai][bj][m][n]) : "v"(Bt##8[n]), "v"(At##8[m]), "v"(f8sa), "v"(f8sb)); } \
            else { _Pragma("unroll") for (int m = 0; m < 4; ++m) _Pragma("unroll") for (int n = 0; n < 2; ++n) \
                asm volatile("v_mfma_scale_f32_16x16x128_f8f6f4 %0, %1, %2, %0, %3, %4 op_sel_hi:[0,0,0]" : "+v"(acc[ai][bj][m][n]) : "v"(Bt##8[n]), "v"(At##8[m]), "v"(f8sa), "v"(f8sb)); } } \
        else { _Pragma("unroll") for (int m = 0; m < 4; ++m) _Pragma("unroll") for (int n = 0; n < 2; ++n) _Pragma("unroll") for (int k = 0; k < 2; ++k) \
            acc[ai][bj][m][n] = __builtin_amdgcn_mfma_f32_16x16x32_bf16(Bt[n][k], At[m][k], acc[ai][bj][m][n], 0, 0, 0); } \
        __builtin_amdgcn_s_setprio(0); } while (0)
#define PG8_WAIT_V(n) asm volatile("s_waitcnt vmcnt(" #n ")" ::: "memory")
#define PG8_WAIT_L(n) asm volatile("s_waitcnt lgkmcnt(" #n ")" ::: "memory")
#define PG8_BAR __builtin_amdgcn_s_barrier()
#define PG8_SCHED __builtin_amdgcn_sched_barrier(0)
    Unit cur, nxt; int ui = 0;
    if (!S.next(0, cur)) return;
    f32x4 acc[2][2][4][2];
    if constexpr (!FP8)
#pragma unroll
    for (int a = 0; a < 2; ++a)
#pragma unroll
        for (int b = 0; b < 2; ++b)
#pragma unroll
            for (int m = 0; m < 4; ++m)
#pragma unroll
                for (int n = 0; n < 2; ++n) acc[a][b][m][n] = (f32x4){0.f, 0.f, 0.f, 0.f};
    bf16x8 At[4][2], B0[2][2], B1[2][2]; i32x8 At8[4], B08[2], B18[2];
    (void)At; (void)B0; (void)B1; (void)At8; (void)B08; (void)B18;
    int f8sa = 0x01010101 * (127 + F8SHIFT), f8sb = 0x7f7f7f7f; asm volatile("" : "+v"(f8sa), "+v"(f8sb)); (void)f8sa; (void)f8sb;
    const char* cA = (const char*)Aop + (GATHER ? (size_t)0 : (size_t)cur.at * tstep); const char* cB = (const char*)Bop + (size_t)cur.bt * tstep;
    if constexpr (GATHER) { PG8_GIDX(vAc, 0); }
    if constexpr (SP2) {
        PG8_STAGE(PG8_SB(0, 0), cB, voffB); PG8_STAGE(PG8_SB(0, 1), cB + bh1, voffB); PG8_STAGE_A(PG8_SA(0, 0), cA, 0, false); PG8_STAGE_A(PG8_SA(0, 1), cA, 1, false);
        if (wr == 1) PG8_BAR;
        PG8_WAIT_V(2); PG8_BAR;
        PG8_STAGE(PG8_SB(1, 0), cB + kstep, voffB); PG8_STAGE_A(PG8_SA(1, 0), cA + kstep, 0, false); PG8_STAGE(PG8_SB(1, 1), cB + bh1 + kstep, voffB);
        PG8_WAIT_V(6); PG8_BAR;
    } else {
        PG8_STAGE(PG8_SB(0, 0), cB, voffB); PG8_STAGE_A(PG8_SA(0, 0), cA, 0, false); PG8_STAGE(PG8_SB(0, 1), cB + bh1, voffB); PG8_STAGE_A(PG8_SA(0, 1), cA, 1, false);
        if (wr == 1) PG8_BAR;
        PG8_WAIT_V(4); PG8_BAR;
        PG8_STAGE(PG8_SB(1, 0), cB + kstep, voffB); PG8_STAGE_A(PG8_SA(1, 0), cA + kstep, 0, false); PG8_STAGE(PG8_SB(1, 1), cB + bh1 + kstep, voffB);
        PG8_WAIT_V(6); PG8_BAR;
    }
    for (;;) {
        const bool has_next = S.next(ui + 1, nxt);
        const char* nA = (has_next && !GATHER) ? (const char*)Aop + (size_t)nxt.at * tstep : cA; const char* nB = has_next ? (const char*)Bop + (size_t)nxt.bt * tstep : cB;
        if constexpr (GATHER) { if (has_next) { PG8_GIDX(vAn, ui + 1); } else {
#pragma unroll
            for (int _h = 0; _h < 2; ++_h) { vAn[_h][0] = vAc[_h][0]; vAn[_h][1] = vAc[_h][1]; } } }
#pragma nounroll
        for (int t = 0; t < nt; t += 2) {
            const bool last = (t == nt - 2);
            const char* a1 = cA + (size_t)(t + 1) * kstep;
            const char* a2 = last ? nA : cA + (size_t)(t + 2) * kstep; const char* b2 = last ? nB : cB + (size_t)(t + 2) * kstep;
            const char* a3 = a2 + kstep; const char* b3 = b2 + kstep;
            if constexpr (SP2) {
            bool zc = FP8 && (t == 0); (void)zc;
            PG8_LDB(B0, 0, 0); PG8_LDB(B1, 0, 1); PG8_SCHED; PG8_LDA(At, 0, 0); PG8_STAGE_A(PG8_SA(1, 1), a1, 1, false);
            PG8_WAIT_V(8); PG8_WAIT_L(0); PG8_BAR; PG8_MMA(0, 0, At, B0); PG8_MMA(0, 1, At, B1); PG8_BAR; PG8_SCHED;
            PG8_LDA(At, 0, 1); PG8_STAGE(PG8_SB(0, 0), b2, voffB); PG8_STAGE(PG8_SB(0, 1), b2 + bh1, voffB); PG8_STAGE_A(PG8_SA(0, 0), a2, 0, last);
            PG8_WAIT_V(8); PG8_WAIT_L(0); PG8_BAR; PG8_MMA(1, 0, At, B0); PG8_MMA(1, 1, At, B1); PG8_BAR; PG8_SCHED;
            zc = false;
            PG8_LDB(B0, 1, 0); PG8_LDB(B1, 1, 1); PG8_SCHED; PG8_LDA(At, 1, 0); PG8_STAGE_A(PG8_SA(0, 1), a2, 1, last);
            PG8_WAIT_V(8); PG8_WAIT_L(0); PG8_BAR; PG8_MMA(0, 0, At, B0); PG8_MMA(0, 1, At, B1); PG8_BAR; PG8_SCHED;
            PG8_LDA(At, 1, 1); PG8_STAGE(PG8_SB(1, 0), b3, voffB); PG8_STAGE(PG8_SB(1, 1), b3 + bh1, voffB); PG8_STAGE_A(PG8_SA(1, 0), a3, 0, last);
            PG8_WAIT_V(8); PG8_WAIT_L(0); PG8_BAR; PG8_MMA(1, 0, At, B0); PG8_MMA(1, 1, At, B1); PG8_BAR; PG8_SCHED;
            } else {
            bool zc = FP8 && (t == 0); (void)zc;
            PG8_LDB(B0, 0, 0); PG8_SCHED; PG8_LDA(At, 0, 0); PG8_STAGE_A(PG8_SA(1, 1), a1, 1, false);
            PG8_WAIT_L(8); PG8_BAR; PG8_WAIT_L(0); PG8_MMA(0, 0, At, B0); PG8_BAR; PG8_SCHED;
            PG8_LDB(B1, 0, 1); PG8_STAGE(PG8_SB(0, 0), b2, voffB);
            PG8_BAR; PG8_WAIT_L(0); PG8_MMA(0, 1, At, B1); PG8_BAR;
            PG8_LDA(At, 0, 1); PG8_STAGE_A(PG8_SA(0, 0), a2, 0, last);
            PG8_BAR; PG8_WAIT_L(0); PG8_MMA(1, 0, At, B0); PG8_BAR; PG8_SCHED;
            PG8_STAGE(PG8_SB(0, 1), b2 + bh1, voffB);
            PG8_WAIT_V(6); PG8_BAR; PG8_MMA(1, 1, At, B1); PG8_BAR;
            zc = false;
            PG8_LDB(B0, 1, 0); PG8_SCHED; PG8_LDA(At, 1, 0); PG8_STAGE_A(PG8_SA(0, 1), a2, 1, last);
            PG8_WAIT_L(8); PG8_BAR; PG8_WAIT_L(0); PG8_MMA(0, 0, At, B0); PG8_BAR; PG8_SCHED;
            PG8_LDB(B1, 1, 1); PG8_STAGE(PG8_SB(1, 0), b3, voffB);
            PG8_BAR; PG8_WAIT_L(0); PG8_MMA(0, 1, At, B1); PG8_BAR;
            PG8_LDA(At, 1, 1); PG8_STAGE_A(PG8_SA(1, 0), a3, 0, last);
            PG8_BAR; PG8_WAIT_L(0); PG8_MMA(1, 0, At, B0); PG8_BAR; PG8_SCHED;
            PG8_STAGE(PG8_SB(1, 1), b3 + bh1, voffB);
            PG8_WAIT_V(6); PG8_BAR; PG8_MMA(1, 1, At, B1); PG8_BAR;
            }
        }
        if constexpr (FP8) asm volatile("s_nop 15\n\ts_nop 15" ::: "memory");
        if constexpr (ALIGN_EPI) { if (wr == 0) PG8_BAR; }
        E(acc, cur, wr, wc, fr, fq);
        if (!has_next) break;
        if constexpr (!FP8)
#pragma unroll
        for (int a = 0; a < 2; ++a)
#pragma unroll
            for (int b = 0; b < 2; ++b)
#pragma unroll
                for (int m = 0; m < 4; ++m)
#pragma unroll
                    for (int n = 0; n < 2; ++n) acc[a][b][m][n] = (f32x4){0.f, 0.f, 0.f, 0.f};
        cur = nxt; cA = nA; cB = nB; ++ui;
        if constexpr (GATHER) {
#pragma unroll
            for (int _h = 0; _h < 2; ++_h) { vAc[_h][0] = vAn[_h][0]; vAc[_h][1] = vAn[_h][1]; } }
        if constexpr (ALIGN_EPI) { if (wr == 1) PG8_BAR; }
    }
    PG8_WAIT_V(0);
    if constexpr (!ALIGN_EPI) { if (wr == 0) PG8_BAR; }
    PG8_BAR;
#undef PG8_GIDX
#undef PG8_SA
#undef PG8_SB
#undef PG8_STAGE
#undef PG8_STAGE_A
#undef PG8_LDA
#undef PG8_LDB
#undef PG8_MMA
#undef PG8_LD8
#undef PG8_WAIT_V
#undef PG8_WAIT_L
#undef PG8_BAR
#undef PG8_SCHED
}
}
#ifndef PG8_SP2
#define PG8_SP2 true
#endif
#ifndef PG8_ALIGN
#define PG8_ALIGN true
#endif
#ifndef MK_FUSED
#define MK_FUSED 1
#endif

constexpr int NWAVES = 8;
constexpr int BATCH = 2, SEQ = 16384, D = 1024, T = BATCH * SEQ;
constexpr int IN_COLS = 5648, NPROJ = 5632;
constexpr int GH = 4, GDK = 128, GDV = 256, GRANK = 16;
constexpr int PW = 512;
constexpr int NE = 64, TOPK = 8, NGRP = 8, FF = 256;
constexpr float LN_EPS = 1e-5f, RMS_EPS = 1e-6f;
constexpr float DN_ALPHA = 1.189207115002721f;
constexpr float ROUTE_SCALE = 2.5f;
constexpr int ROUTED_TILES = 1088, SH_TILES = T / 256;
constexpr float Y_SCALE = 16.0f;
constexpr float W_SCALE = 32.0f, H_SCALE = 16.0f;
constexpr int ALL_ROWS = (ROUTED_TILES + SH_TILES) * 256;

constexpr size_t MiB = 1u << 20;
constexpr size_t WS_CTL = 0, CTL_ZERO_BYTES = 1 * MiB;
constexpr size_t WS_TAB = 1 * MiB;
constexpr size_t TAB_CNT = WS_TAB, TAB_TILEE = WS_TAB + 65536, TAB_META = WS_TAB + 73728, TAB_STATS = WS_TAB + 262144;
constexpr size_t WS_WIN = 2 * MiB, WS_WGLA = 13 * MiB, WS_WPC = 15 * MiB, WS_WOUT = 16 * MiB;
constexpr size_t WS_GLR = 18 * MiB;
constexpr size_t WS_L = 20 * MiB;
constexpr size_t WS_XB = 52 * MiB;
constexpr size_t WS_PO = 52 * MiB, WS_OG = 84 * MiB;
constexpr size_t WS_QK = 148 * MiB, WS_V = 212 * MiB, WS_R = 276 * MiB, WS_U = 340 * MiB, WS_GA = 372 * MiB, WS_GB = 436 * MiB;
constexpr size_t WS_T1 = WS_QK, WS_MG = WS_V;
constexpr size_t WS_TOKE = 2 * MiB, WS_TOKW = 3 * MiB, WS_TOKLR = 4 * MiB, WS_TOKSLOT = 5 * MiB, WS_ROWTOK = 6 * MiB, WS_ROWW = 8 * MiB;
constexpr size_t WS_H1F = 10 * MiB;
constexpr size_t WS_W1 = 42 * MiB;
constexpr size_t WS_Y = 10 * MiB;
constexpr size_t WS_H = 319 * MiB;
constexpr size_t WS_W2 = 479 * MiB;
constexpr size_t WS_PST = 500 * MiB;
constexpr size_t WS_END = 512 * MiB;
static_assert(WS_WIN + (size_t)NPROJ * D * 2 <= WS_WGLA && WS_GB + (size_t)T * D * 2 <= 500 * MiB, "map 1");
static_assert(WS_ROWTOK + (size_t)ALL_ROWS * 4 <= WS_ROWW && WS_ROWW + (size_t)ALL_ROWS * 4 <= WS_H1F && WS_H1F + (size_t)T * D <= WS_W1, "map 2");
static_assert(WS_W1 + (size_t)65 * 512 * 1024 <= WS_H && WS_Y + (size_t)ROUTED_TILES * 256 * 1024 <= WS_H && WS_H + (size_t)ALL_ROWS * 256 <= WS_W2 && WS_W2 + (size_t)65 * 1024 * 256 <= WS_PST, "map 3");
constexpr int CW_TMO = 0, CW_CODE = 1;
constexpr int CW_BAR = 4096;
constexpr int MT_NT = 0, MT_ESTART = 16, MT_ECNT = 96;

constexpr int RING_OFF = 0, RING_BYTES = 131072;
constexpr int IDX_OFF = RING_BYTES, IDX_UNITS = 12, IDX_BYTES = IDX_UNITS * 1024;
constexpr int LDSCTL_OFF = IDX_OFF + IDX_BYTES, MISC_OFF = LDSCTL_OFF + 320;
constexpr int LDS_BYTES = 147456;
static_assert(MISC_OFF + 128 <= LDS_BYTES, "LDS map");

#define GAS __attribute__((address_space(1)))
#define LAS __attribute__((address_space(3)))
typedef unsigned short bf16;
typedef unsigned v4u __attribute__((ext_vector_type(4)));
typedef unsigned v2u __attribute__((ext_vector_type(2)));
typedef float f32x4 __attribute__((ext_vector_type(4)));
typedef float f32x2 __attribute__((ext_vector_type(2)));
typedef GAS unsigned gu32;
#define RLX_AGENT __ATOMIC_RELAXED, __HIP_MEMORY_SCOPE_AGENT
#define LDS_WAIT() asm volatile("s_waitcnt lgkmcnt(0)" ::: "memory")
#define VM_WAIT() asm volatile("s_waitcnt vmcnt(0)" ::: "memory")
__device__ __forceinline__ unsigned f2bf(float f) { unsigned u = __builtin_bit_cast(unsigned, f); return (u + 0x7fffu + ((u >> 16) & 1u)) >> 16; }
__device__ __forceinline__ unsigned pk2(float lo, float hi) { return f2bf(lo) | (f2bf(hi) << 16); }
__device__ __forceinline__ float bf2f(bf16 b) { return __uint_as_float((unsigned)b << 16); }
__device__ __forceinline__ float blo(unsigned w) { return __uint_as_float(w << 16); }
__device__ __forceinline__ float bhi(unsigned w) { return __uint_as_float(w & 0xffff0000u); }
__device__ __forceinline__ float sigmoidf_(float x) { return 1.0f / (1.0f + __expf(-x)); }

#define XB_TMO      128
#define XB_XCNT(j)  (256  + 64 * (j))
#define XB_XSUB(j)  (1280 + 64 * (j))
#define XB_XGEN(j)  (2304 + 64 * (j))
#define XB_TOP      3328
#define XB_TOPGEN   3392
#define XCD_BAR_WORDS 3456
#define XB_SPIN_CAP (1u << 18)

__device__ __forceinline__ unsigned xb_ld(unsigned* p)              { return __hip_atomic_load(p, __ATOMIC_RELAXED, __HIP_MEMORY_SCOPE_AGENT); }
__device__ __forceinline__ unsigned xb_add(unsigned* p, unsigned v) { return __hip_atomic_fetch_add(p, v, __ATOMIC_RELAXED, __HIP_MEMORY_SCOPE_AGENT); }
__device__ __forceinline__ unsigned xb_xcc_id() { return (unsigned)__builtin_amdgcn_s_getreg((3 << 11) | 20) & 0xFu; }
#define XB_SPIN(cond, bar) do { unsigned _sp = 0; while (cond) { __builtin_amdgcn_s_sleep(1); \
    if ((++_sp & 255u) == 0u) { if (xb_ld(&(bar)[XB_TMO])) break; if (_sp > XB_SPIN_CAP) { atomicAdd(&(bar)[XB_TMO], 1u); break; } } } } while (0)

struct XcdBarrier { unsigned* bar; unsigned x; volatile LAS unsigned* st; };

__device__ __forceinline__ XcdBarrier xcd_barrier_post(unsigned* bar, volatile LAS unsigned* st) {
    XcdBarrier b; b.bar = bar; b.x = xb_xcc_id(); b.st = st;
    if (threadIdx.x == 0) (void)xb_add(&bar[XB_XCNT(b.x)], 1u);
    return b;
}
__device__ __forceinline__ void xcd_barrier_complete(unsigned* bar, unsigned x, unsigned& nloc, unsigned& nx) {
    const unsigned G = gridDim.x * gridDim.y * gridDim.z;
    unsigned sum, cnt, mine, sp = 0u;
    for (;;) {
        sum = 0u; cnt = 0u; mine = 0u;
#pragma unroll
        for (unsigned j = 0; j < 16; ++j) { const unsigned c = xb_ld(&bar[XB_XCNT(j)]); sum += c; cnt += (c > 0u) ? 1u : 0u; mine = (j == x) ? c : mine; }
        if (sum == G) break;
        __builtin_amdgcn_s_sleep(1);
        if ((++sp & 255u) == 0u) { if (xb_ld(&bar[XB_TMO])) break; if (sp > XB_SPIN_CAP) { atomicAdd(&bar[XB_TMO], 1u); break; } }
    }
    nloc = mine > 0u ? mine : 1u; nx = cnt > 0u ? cnt : 1u;
}
__device__ __forceinline__ void xcd_barrier(const XcdBarrier& b) {
    asm volatile("s_waitcnt vmcnt(0)" ::: "memory");
    __syncthreads();
    if (threadIdx.x == 0) {
        unsigned* bar = b.bar;
        __builtin_amdgcn_s_waitcnt(0);
        unsigned nloc = b.st[0], nx = b.st[1];
        if (nloc == 0u) { xcd_barrier_complete(bar, b.x, nloc, nx); b.st[0] = nloc; b.st[1] = nx; }
        const unsigned old = xb_add(&bar[XB_XSUB(b.x)], 1u);
        const unsigned gen = old / nloc;
        if (old + 1u == (gen + 1u) * nloc) {
            __builtin_amdgcn_fence(__ATOMIC_RELEASE, "agent");
            asm volatile("s_waitcnt vmcnt(0)" ::: "memory");
            const unsigned og = xb_add(&bar[XB_TOP], 1u);
            const unsigned tg = og / nx;
            if (og + 1u == (tg + 1u) * nx) xb_add(&bar[XB_TOPGEN], 1u);
            else XB_SPIN(xb_ld(&bar[XB_TOPGEN]) == tg, bar);
            __builtin_amdgcn_fence(__ATOMIC_ACQUIRE, "agent");
            xb_add(&bar[XB_XGEN(b.x)], 1u);
            asm volatile("s_waitcnt vmcnt(0)" ::: "memory");
        } else {
            XB_SPIN(xb_ld(&bar[XB_XGEN(b.x)]) == gen, bar);
            __builtin_amdgcn_fence(__ATOMIC_ACQUIRE, "agent");
            asm volatile("s_waitcnt vmcnt(0)" ::: "memory");
        }
    }
    __syncthreads();
}

struct Frame {
    LAS unsigned char* lds;
    volatile LAS unsigned* MISC;
    gu32* ctl;
    unsigned char* ws;
    int tid, lane, wave;
    int vcu, G;
    const float *x, *w_in, *w_gate_up, *b_gate, *gla_norm_g, *w_gla_up, *w_pool_grp, *pool_scale, *w_pool_up, *w_out, *ln1_g, *ln1_b, *w_router, *router_bias,
                *w_exp_gate, *w_exp_up, *w_exp_down, *w_sh_gate, *w_sh_up, *w_sh_down, *ln2_g, *ln2_b;
    float* out;
};
template <int CTRL> __device__ __forceinline__ float dppf(float x) { return __builtin_bit_cast(float, __builtin_amdgcn_mov_dpp(__builtin_bit_cast(int, x), CTRL, 0xf, 0xf, true)); }
template <int CTRL> __device__ __forceinline__ int dppi(int x) { return __builtin_amdgcn_mov_dpp(x, CTRL, 0xf, 0xf, true); }
constexpr int DPP_XOR1 = 0xB1, DPP_XOR2 = 0x4E, DPP_ROR4 = 0x124, DPP_ROR8 = 0x128, DPP_Q0 = 0x00, DPP_Q1 = 0x55, DPP_Q2 = 0xAA, DPP_Q3 = 0xFF;
__device__ __forceinline__ float xrow16_sumf(float x) {
    auto s = __builtin_amdgcn_permlane16_swap(__float_as_uint(x), __float_as_uint(x), false, false);
    x = __uint_as_float(s[0]) + __uint_as_float(s[1]);
    auto t = __builtin_amdgcn_permlane32_swap(__float_as_uint(x), __float_as_uint(x), false, false);
    return __uint_as_float(t[0]) + __uint_as_float(t[1]);
}
__device__ __forceinline__ float wave_sum(float v) {
    v += dppf<DPP_XOR1>(v); v += dppf<DPP_XOR2>(v); v += dppf<DPP_ROR4>(v); v += dppf<DPP_ROR8>(v);
    return xrow16_sumf(v);
}
#ifdef NT_LOADS
#define NTL(p_) __builtin_nontemporal_load(p_)
#else
#define NTL(p_) (*(p_))
#endif
#define LDS_BARRIER() do { asm volatile("s_waitcnt lgkmcnt(0)" ::: "memory"); __builtin_amdgcn_s_barrier(); asm volatile("" ::: "memory"); } while (0)
typedef __bf16 bf16x2_t __attribute__((ext_vector_type(2)));
__device__ __forceinline__ unsigned cvtpk(float lo, float hi) { f32x2 v = {lo, hi}; bf16x2_t b = __builtin_convertvector(v, bf16x2_t); return __builtin_bit_cast(unsigned, b); }
__device__ __forceinline__ void tr_item(const float* W, int ldw, int k0, int n0s, bf16* WT, int ldd, int n0d, float scale, LAS float* scr, int lane) {
    float tv[32];
#pragma unroll
    for (int i = 0; i < 32; ++i) { const int kk = 2 * i + (lane >> 5); tv[i] = W[(size_t)(k0 + kk) * ldw + n0s + (lane & 31)]; }
#pragma unroll
    for (int i = 0; i < 32; ++i) { const int kk = 2 * i + (lane >> 5); scr[kk * 33 + (lane & 31)] = tv[i] * scale; }
    LDS_WAIT(); asm volatile("" ::: "memory");
    const int c = lane & 7;
#pragma unroll
    for (int j = 0; j < 4; ++j) { const int n = (lane >> 3) + 8 * j; const LAS float* s = scr + (8 * c) * 33 + n;
        v4u o; o.x = pk2(s[0 * 33], s[1 * 33]); o.y = pk2(s[2 * 33], s[3 * 33]); o.z = pk2(s[4 * 33], s[5 * 33]); o.w = pk2(s[6 * 33], s[7 * 33]);
        *(GAS v4u*)(WT + (size_t)(n0d + n) * ldd + k0 + 8 * c) = o; }
    LDS_WAIT(); asm volatile("" ::: "memory");
}

__device__ __forceinline__ void tr_item8(const float* W, int ldw, int k0, int n0s, unsigned char* WT, int ldd, int n0d, float scale, LAS float* scr, int lane) {
    float tv[32];
#pragma unroll
    for (int i = 0; i < 32; ++i) { const int kk = 2 * i + (lane >> 5); tv[i] = W[(size_t)(k0 + kk) * ldw + n0s + (lane & 31)]; }
#pragma unroll
    for (int i = 0; i < 32; ++i) { const int kk = 2 * i + (lane >> 5); scr[kk * 33 + (lane & 31)] = tv[i] * scale; }
    LDS_WAIT(); asm volatile("" ::: "memory");
#pragma unroll
    for (int j = 0; j < 2; ++j) { const int c = lane + 64 * j, n = c >> 2, kc = c & 3; const LAS float* sp = scr + (16 * kc) * 33 + n;
        v4u o; o.x = pg8::pk4_fp8(sp[0 * 33], sp[1 * 33], sp[2 * 33], sp[3 * 33]); o.y = pg8::pk4_fp8(sp[4 * 33], sp[5 * 33], sp[6 * 33], sp[7 * 33]);
        o.z = pg8::pk4_fp8(sp[8 * 33], sp[9 * 33], sp[10 * 33], sp[11 * 33]); o.w = pg8::pk4_fp8(sp[12 * 33], sp[13 * 33], sp[14 * 33], sp[15 * 33]);
        *(GAS v4u*)(WT + (size_t)(n0d + n) * ldd + k0 + 16 * kc) = o; }
    LDS_WAIT(); asm volatile("" ::: "memory");
}
__device__ __forceinline__ void router_prep(Frame& F);
__device__ __forceinline__ void p0_prologue(Frame& F) {
    LAS float* scr = (LAS float*)(F.lds + RING_OFF + F.wave * 16384);
    const int gw = F.vcu * NWAVES + F.wave, NGW = F.G * NWAVES;
    bf16* Win = (bf16*)(F.ws + WS_WIN); bf16* Wgla = (bf16*)(F.ws + WS_WGLA); bf16* Wpc = (bf16*)(F.ws + WS_WPC); bf16* Wout = (bf16*)(F.ws + WS_WOUT);
    constexpr int I_IN = 16 * (NPROJ / 32), I_SQ = 16 * 32;
    for (int it = gw; it < I_IN + 2 * I_SQ; it += NGW) {
        int r = it;
        if (r < I_IN) { const int kb = r / (NPROJ / 32), nb = r % (NPROJ / 32), n0d = 32 * nb, n0s = n0d < 3072 ? n0d : n0d + 16;
            tr_item(F.w_in, IN_COLS, 64 * kb, n0s, Win, D, n0d, n0d < 512 ? 0.08838834764831845f : 1.0f, scr, F.lane); continue; }
        r -= I_IN;
        if (r < I_SQ) { tr_item(F.w_gla_up, D, 64 * (r / 32), 32 * (r % 32), Wgla, D, 32 * (r % 32), 1.0f, scr, F.lane); continue; }
        r -= I_SQ;
        tr_item(F.w_out, D, 64 * (r / 32), 32 * (r % 32), Wout, D, 32 * (r % 32), 1.0f, scr, F.lane);
    }
    __syncthreads();
    for (int it = F.vcu; it < 4 * 32; it += F.G) {
        const int g = it >> 5, n0 = (it & 31) * 32;
        LAS float* As = (LAS float*)(F.lds + RING_OFF); LAS float* Bs = As + 128 * 129;
        for (int i = F.tid; i < 128 * 128; i += NWAVES * 64) { const int c = i >> 7, e = i & 127; As[c * 129 + e] = F.w_pool_grp[(size_t)(g * 128 + c) * 128 + e] * F.pool_scale[g * 128 + e]; }
        for (int i = F.tid; i < 128 * 32; i += NWAVES * 64) { const int e = i >> 5, n = i & 31; Bs[e * 33 + n] = F.w_pool_up[(size_t)(g * 128 + e) * D + n0 + n]; }
        __syncthreads();
        { const int n = F.tid & 31, cg = F.tid >> 5; float a[8];
#pragma unroll
          for (int i = 0; i < 8; ++i) a[i] = 0.f;
#pragma unroll 4
          for (int e = 0; e < 128; ++e) { const float bv = Bs[e * 33 + n];
#pragma unroll
              for (int i = 0; i < 8; ++i) a[i] += As[(8 * cg + i) * 129 + e] * bv; }
          v4u o; o.x = pk2(a[0], a[1]); o.y = pk2(a[2], a[3]); o.z = pk2(a[4], a[5]); o.w = pk2(a[6], a[7]);
          *(GAS v4u*)(Wpc + (size_t)(n0 + n) * PW + g * 128 + 8 * cg) = o; }
        __syncthreads();
    }
    router_prep(F);
    __syncthreads();
    { LAS v4u* wf = (LAS v4u*)(F.lds + RING_OFF);
      for (int id = F.tid; id < 32 * 2 * 64; id += NWAVES * 64) { const int ln = id & 63, pp = (id >> 6) & 1, ks = id >> 7, r = ln & 15, dbase = 32 * ks + 8 * (ln >> 4);
          float v[8];
#pragma unroll
          for (int j = 0; j < 8; ++j) { const float w = F.w_in[(size_t)(dbase + j) * IN_COLS + 3072 + r]; const float hi = __uint_as_float(f2bf(w) << 16); v[j] = pp ? (w - hi) : w; }
          v4u o; o.x = pk2(v[0], v[1]); o.y = pk2(v[2], v[3]); o.z = pk2(v[4], v[5]); o.w = pk2(v[6], v[7]); wf[id] = o; }
      __syncthreads();
      bf16* XB = (bf16*)(F.ws + WS_XB); float* GLR = (float*)(F.ws + WS_GLR);
      const int row = F.lane & 15, kg = F.lane >> 4;
      for (int tile = gw; tile < T / 16; tile += NGW) {
          const int t0 = tile * 16;
          const GAS f32x4* xp = (const GAS f32x4*)(F.x + (size_t)(t0 + row) * D + 8 * kg);
          GAS v4u* ob = (GAS v4u*)(XB + (size_t)(t0 + row) * D + 8 * kg);
          pg8::f32x4 acc = (pg8::f32x4){0.f, 0.f, 0.f, 0.f};
#pragma unroll 8
          for (int ks = 0; ks < 32; ++ks) {
              const f32x4 x0 = NTL(xp + 8 * ks), x1 = NTL(xp + 8 * ks + 1);
              v4u ah; ah.x = cvtpk(x0.x, x0.y); ah.y = cvtpk(x0.z, x0.w); ah.z = cvtpk(x1.x, x1.y); ah.w = cvtpk(x1.z, x1.w);
              v4u al; al.x = cvtpk(x0.x - blo(ah.x), x0.y - bhi(ah.x)); al.y = cvtpk(x0.z - blo(ah.y), x0.w - bhi(ah.y)); al.z = cvtpk(x1.x - blo(ah.z), x1.y - bhi(ah.z)); al.w = cvtpk(x1.z - blo(ah.w), x1.w - bhi(ah.w));
              ob[4 * ks] = ah;
              const pg8::bf16x8 Ah = __builtin_bit_cast(pg8::bf16x8, ah), Al = __builtin_bit_cast(pg8::bf16x8, al);
              const pg8::bf16x8 bh = __builtin_bit_cast(pg8::bf16x8, wf[(ks * 2 + 0) * 64 + F.lane]), bl = __builtin_bit_cast(pg8::bf16x8, wf[(ks * 2 + 1) * 64 + F.lane]);
              acc = __builtin_amdgcn_mfma_f32_16x16x32_bf16(Ah, bh, acc, 0, 0, 0);
              acc = __builtin_amdgcn_mfma_f32_16x16x32_bf16(Al, bh, acc, 0, 0, 0);
              acc = __builtin_amdgcn_mfma_f32_16x16x32_bf16(Ah, bl, acc, 0, 0, 0);
          }
#pragma unroll
          for (int r = 0; r < 4; ++r) GLR[(size_t)(t0 + 4 * kg + r) * GRANK + row] = acc[r];
      }
    }
}

template <int WIN> __device__ __forceinline__ void pool_item(const bf16* U, bf16* PO, int t, int c8) {
    const int pos = t & (SEQ - 1);
    v4u w[WIN];
#pragma unroll
    for (int j = 0; j < WIN; ++j) { const int tj = (j <= pos) ? t - j : t; w[j] = *(const GAS v4u*)(U + (size_t)tj * PW + c8 * 8); }
    float s[8];
#pragma unroll
    for (int q = 0; q < 8; ++q) s[q] = 0.f;
#pragma unroll
    for (int j = 0; j < WIN; ++j) { const float m = (j <= pos) ? 1.f : 0.f;
        s[0] += m * blo(w[j].x); s[1] += m * bhi(w[j].x); s[2] += m * blo(w[j].y); s[3] += m * bhi(w[j].y); s[4] += m * blo(w[j].z); s[5] += m * bhi(w[j].z); s[6] += m * blo(w[j].w); s[7] += m * bhi(w[j].w); }
    const int cnt = (pos + 1 < WIN) ? pos + 1 : WIN; const float ic = 1.0f / (float)cnt; const v4u cur = w[0];
    v4u o; o.x = pk2(s[0] * ic - blo(cur.x), s[1] * ic - bhi(cur.x)); o.y = pk2(s[2] * ic - blo(cur.y), s[3] * ic - bhi(cur.y));
    o.z = pk2(s[4] * ic - blo(cur.z), s[5] * ic - bhi(cur.z)); o.w = pk2(s[6] * ic - blo(cur.w), s[7] * ic - bhi(cur.w));
    *(GAS v4u*)(PO + (size_t)t * PW + c8 * 8) = o;
}
template <int WIN> __device__ __forceinline__ void pool_loop(Frame& F, const bf16* U, bf16* PO, int grp) {
    const int gw = F.vcu * NWAVES + F.wave, NGW = F.G * NWAVES;
#pragma unroll 2
    for (int it = gw; it < (T / 4) * 4; it += NGW) pool_item<WIN>(U, PO, (it >> 2) * 4 + (F.lane >> 4), grp * 16 + (F.lane & 15));
}
__device__ __forceinline__ void pool_phase(Frame& F) {
    const bf16* U = (const bf16*)(F.ws + WS_U); bf16* PO = (bf16*)(F.ws + WS_PO);
    const int grp = (F.vcu * NWAVES + F.wave) & 3;
    if ((F.G * NWAVES) & 3) {
        const int gw = F.vcu * NWAVES + F.wave, NGW = F.G * NWAVES;
        for (int it = gw; it < (T / 4) * 4; it += NGW) { const int tq = it >> 2, g2 = it & 3, t = tq * 4 + (F.lane >> 4), c8 = g2 * 16 + (F.lane & 15);
            if (g2 == 0) pool_item<2>(U, PO, t, c8); else if (g2 == 1) pool_item<4>(U, PO, t, c8); else if (g2 == 2) pool_item<8>(U, PO, t, c8); else pool_item<16>(U, PO, t, c8); }
        return;
    }
    if (grp == 0) pool_loop<2>(F, U, PO, 0); else if (grp == 1) pool_loop<4>(F, U, PO, 1); else if (grp == 2) pool_loop<8>(F, U, PO, 2); else pool_loop<16>(F, U, PO, 3);
}

__device__ __forceinline__ void expert_w1_phase(Frame& F) {
    LAS float* scr = (LAS float*)(F.lds + RING_OFF + F.wave * 16384);
    const int gw = F.vcu * NWAVES + F.wave, NGW = F.G * NWAVES;
    unsigned char* W1 = F.ws + WS_W1;
    for (int it = gw; it < 65 * 2 * 128; it += NGW) {
        const int e = it >> 8, mat = (it >> 7) & 1, kb = (it >> 3) & 15, nb = it & 7, f0 = 32 * nb;
        const float* src = (e < NE) ? ((mat ? F.w_exp_up : F.w_exp_gate) + (size_t)e * D * FF) : (mat ? F.w_sh_up : F.w_sh_gate);
        tr_item8(src, FF, 64 * kb, f0, W1 + (size_t)e * 512 * D, D, 256 * (f0 >> 7) + (f0 & 127) + 128 * mat, W_SCALE, scr, F.lane);
    }
}
__device__ __forceinline__ void expert_w2_phase(Frame& F) {
    LAS float* scr = (LAS float*)(F.lds + RING_OFF + F.wave * 16384);
    const int gw = F.vcu * NWAVES + F.wave, NGW = F.G * NWAVES;
    unsigned char* W2 = F.ws + WS_W2;
    for (int it = gw; it < 65 * 128; it += NGW) {
        const int e = it >> 7, kb = (it >> 5) & 3, nb = it & 31;
        const float* src = (e < NE) ? (F.w_exp_down + (size_t)e * FF * D) : F.w_sh_down;
        tr_item8(src, D, 64 * kb, 32 * nb, W2 + (size_t)e * D * FF, FF, 32 * nb, W_SCALE, scr, F.lane);
    }
}

constexpr size_t TAB_WRT = WS_TAB + 524288, TAB_CGB = WS_TAB + 786432;
__device__ __forceinline__ void router_prep(Frame& F) {
    v4u* WRT = (v4u*)(F.ws + TAB_WRT);
    const int gt = F.vcu * (NWAVES * 64) + F.tid, NT = F.G * NWAVES * 64;
    for (int id = gt; id < 32 * 4 * 2 * 64; id += NT) {
        const int ln = id & 63, p = (id >> 6) & 1, nt = (id >> 7) & 3, ks = id >> 9, e = 16 * nt + (ln & 15), dbase = 32 * ks + 8 * (ln >> 4);
        float v[8];
#pragma unroll
        for (int j = 0; j < 8; ++j) { const float w = F.w_router[(size_t)(dbase + j) * NE + e]; const float hi = __uint_as_float(f2bf(w) << 16); v[j] = p ? (w - hi) : w; }
        v4u o; o.x = pk2(v[0], v[1]); o.y = pk2(v[2], v[3]); o.z = pk2(v[4], v[5]); o.w = pk2(v[6], v[7]);
        WRT[id] = o;
    }
}
__device__ __forceinline__ void router_phase(Frame& F) {
    const bf16* PRE = (const bf16*)F.out; unsigned char* H1F = F.ws + WS_H1F; float* ST = (float*)(F.ws + TAB_STATS); const float* PST = (const float*)(F.ws + WS_PST);
    int* TOKE = (int*)(F.ws + WS_TOKE); float* TOKW = (float*)(F.ws + WS_TOKW); int* TOKLR = (int*)(F.ws + WS_TOKLR); int* CNT = (int*)(F.ws + TAB_CNT);
    const v4u* WRT = (const v4u*)(F.ws + TAB_WRT);
    LAS float* lgt = (LAS float*)(F.lds + F.wave * 4096);
    LAS int* lcnt = (LAS int*)(F.lds + LDSCTL_OFF);
    LAS float* lgb = (LAS float*)(F.lds + IDX_OFF);
    const int lane = F.lane, row = lane & 15, kg = lane >> 4, q = lane & 3;
    for (int i = F.tid; i < 2 * D; i += NWAVES * 64) lgb[i] = i < D ? F.ln1_g[i] : F.ln1_b[i - D];
    for (int tile = F.vcu; tile < T / 128; tile += F.G) {
        if (F.tid < 64) lcnt[F.tid] = 0;
        __syncthreads();
        const int t0 = tile * 128 + F.wave * 16;
        float mean, rstd;
        { const GAS f32x4* pp = (const GAS f32x4*)(PST + (size_t)(t0 + row) * 32); float s1 = 0.f, s2 = 0.f;
#pragma unroll
          for (int i = 0; i < 8; ++i) { const f32x4 v = pp[i]; s1 += v.x + v.z; s2 += v.y + v.w; }
          mean = s1 * (1.f / D); rstd = 1.f / sqrtf(fmaxf(s2 * (1.f / D) - mean * mean, 0.f) + LN_EPS); }
        if (kg == 0) *(GAS f32x2*)(ST + 2 * (size_t)(t0 + row)) = (f32x2){mean, rstd};
        pg8::f32x4 acc[4];
#pragma unroll
        for (int nt = 0; nt < 4; ++nt) acc[nt] = (pg8::f32x4){0.f, 0.f, 0.f, 0.f};
        const GAS v4u* xp = (const GAS v4u*)(PRE + (size_t)(t0 + row) * 2048 + 8 * kg);
        GAS v2u* ob = (GAS v2u*)(H1F + (size_t)(t0 + row) * D + 8 * kg);
        LAS v4u* wl = (LAS v4u*)(F.lds + RING_OFF);
#pragma unroll 1
        for (int kh = 0; kh < 2; ++kh) {
            { const GAS v4u* src = (const GAS v4u*)WRT + (size_t)kh * 8192 + F.tid; v4u tmp[16];
#pragma unroll
              for (int i = 0; i < 16; ++i) tmp[i] = src[i * 512];
#pragma unroll
              for (int i = 0; i < 16; ++i) wl[F.tid + i * 512] = tmp[i]; }
            __syncthreads();
#pragma unroll 8
            for (int kl = 0; kl < 16; ++kl) {
                const int ks = kh * 16 + kl;
                const v4u xw = NTL(xp + 4 * ks); f32x4 x0 = (f32x4){blo(xw.x), bhi(xw.x), blo(xw.y), bhi(xw.y)}, x1 = (f32x4){blo(xw.z), bhi(xw.z), blo(xw.w), bhi(xw.w)};
                const f32x4 g0 = *(const LAS f32x4*)(lgb + 32 * ks + 8 * kg), g1 = *(const LAS f32x4*)(lgb + 32 * ks + 8 * kg + 4), b0 = *(const LAS f32x4*)(lgb + D + 32 * ks + 8 * kg), b1 = *(const LAS f32x4*)(lgb + D + 32 * ks + 8 * kg + 4);
                x0 = (x0 - mean) * rstd * g0 + b0; x1 = (x1 - mean) * rstd * g1 + b1;
                v4u ah; ah.x = cvtpk(x0.x, x0.y); ah.y = cvtpk(x0.z, x0.w); ah.z = cvtpk(x1.x, x1.y); ah.w = cvtpk(x1.z, x1.w);
                v4u al; al.x = cvtpk(x0.x - blo(ah.x), x0.y - bhi(ah.x)); al.y = cvtpk(x0.z - blo(ah.y), x0.w - bhi(ah.y)); al.z = cvtpk(x1.x - blo(ah.z), x1.y - bhi(ah.z)); al.w = cvtpk(x1.z - blo(ah.w), x1.w - bhi(ah.w));
                ob[4 * ks] = (v2u){pg8::pk4_fp8(x0.x, x0.y, x0.z, x0.w), pg8::pk4_fp8(x1.x, x1.y, x1.z, x1.w)};
                const pg8::bf16x8 Ah = __builtin_bit_cast(pg8::bf16x8, ah), Al = __builtin_bit_cast(pg8::bf16x8, al);
#pragma unroll
                for (int nt = 0; nt < 4; ++nt) { const pg8::bf16x8 bh = __builtin_bit_cast(pg8::bf16x8, wl[((kl * 4 + nt) * 2 + 0) * 64 + lane]), bl = __builtin_bit_cast(pg8::bf16x8, wl[((kl * 4 + nt) * 2 + 1) * 64 + lane]);
                    acc[nt] = __builtin_amdgcn_mfma_f32_16x16x32_bf16(Ah, bh, acc[nt], 0, 0, 0);
                    acc[nt] = __builtin_amdgcn_mfma_f32_16x16x32_bf16(Al, bh, acc[nt], 0, 0, 0);
                    acc[nt] = __builtin_amdgcn_mfma_f32_16x16x32_bf16(Ah, bl, acc[nt], 0, 0, 0); }
            }
            __syncthreads();
        }
#pragma unroll
        for (int r = 0; r < 4; ++r)
#pragma unroll
            for (int nt = 0; nt < 4; ++nt) lgt[(4 * kg + r) * 64 + 16 * nt + row] = acc[nt][r];
        LDS_WAIT(); asm volatile("" ::: "memory");
        {
            const int tk = lane >> 2, t = t0 + tk;
            float sc[16], mb[16];
#pragma unroll
            for (int i4 = 0; i4 < 4; ++i4) { const f32x4 l4 = *(const LAS f32x4*)(lgt + tk * 64 + 16 * q + 4 * i4); const f32x4 b4 = *(const GAS f32x4*)(F.router_bias + 16 * q + 4 * i4);
                sc[4 * i4] = 1.0f / (1.0f + expf(-l4.x)); sc[4 * i4 + 1] = 1.0f / (1.0f + expf(-l4.y)); sc[4 * i4 + 2] = 1.0f / (1.0f + expf(-l4.z)); sc[4 * i4 + 3] = 1.0f / (1.0f + expf(-l4.w));
                mb[4 * i4] = sc[4 * i4] + b4.x; mb[4 * i4 + 1] = sc[4 * i4 + 1] + b4.y; mb[4 * i4 + 2] = sc[4 * i4 + 2] + b4.z; mb[4 * i4 + 3] = sc[4 * i4 + 3] + b4.w; }
            float gs0, gs1;
            { float m1 = -INFINITY, m2 = -INFINITY;
#pragma unroll
              for (int i = 0; i < 8; ++i) { const float v = mb[i]; m2 = fmaxf(m2, fminf(m1, v)); m1 = fmaxf(m1, v); }
              gs0 = m1 + m2; m1 = -INFINITY; m2 = -INFINITY;
#pragma unroll
              for (int i = 8; i < 16; ++i) { const float v = mb[i]; m2 = fmaxf(m2, fminf(m1, v)); m1 = fmaxf(m1, v); }
              gs1 = m1 + m2; }
            float G8[8];
            G8[0] = dppf<DPP_Q0>(gs0); G8[1] = dppf<DPP_Q0>(gs1); G8[2] = dppf<DPP_Q1>(gs0); G8[3] = dppf<DPP_Q1>(gs1); G8[4] = dppf<DPP_Q2>(gs0); G8[5] = dppf<DPP_Q2>(gs1); G8[6] = dppf<DPP_Q3>(gs0); G8[7] = dppf<DPP_Q3>(gs1);
            int rk0 = 0, rk1 = 0;
#pragma unroll
            for (int g = 0; g < 8; ++g) { rk0 += (G8[g] > gs0 || (G8[g] == gs0 && g < 2 * q)) ? 1 : 0; rk1 += (G8[g] > gs1 || (G8[g] == gs1 && g < 2 * q + 1)) ? 1 : 0; }
            const bool sel0 = rk0 < 4, sel1 = rk1 < 4;
#pragma unroll
            for (int i = 0; i < 8; ++i) { mb[i] = sel0 ? mb[i] : -INFINITY; mb[8 + i] = sel1 ? mb[8 + i] : -INFINITY; }
            int eidx[8]; float esc[8]; float ssum = 0.f;
#pragma unroll
            for (int k = 0; k < TOPK; ++k) {
                float lm = mb[0]; int li = 0;
#pragma unroll
                for (int i = 1; i < 16; ++i) { const bool gt = mb[i] > lm; lm = gt ? mb[i] : lm; li = gt ? i : li; }
                float m = fmaxf(lm, dppf<DPP_XOR1>(lm)); m = fmaxf(m, dppf<DPP_XOR2>(m));
                int cand = (lm == m) ? 16 * q + li : 9999;
                int widx = min(cand, dppi<DPP_XOR1>(cand)); widx = min(widx, dppi<DPP_XOR2>(widx));
                const bool mine = (cand == widx); float sv = 0.f;
#pragma unroll
                for (int i = 0; i < 16; ++i) { const bool hit = mine && (i == li); sv = hit ? sc[i] : sv; mb[i] = hit ? -INFINITY : mb[i]; }
                sv += dppf<DPP_XOR1>(sv); sv += dppf<DPP_XOR2>(sv);
                eidx[k] = widx; esc[k] = sv; ssum += sv;
            }
            const float inv = ROUTE_SCALE / ssum;
            const int e0 = q == 0 ? eidx[0] : q == 1 ? eidx[2] : q == 2 ? eidx[4] : eidx[6], e1 = q == 0 ? eidx[1] : q == 1 ? eidx[3] : q == 2 ? eidx[5] : eidx[7];
            const float w0 = (q == 0 ? esc[0] : q == 1 ? esc[2] : q == 2 ? esc[4] : esc[6]) * inv, w1 = (q == 0 ? esc[1] : q == 1 ? esc[3] : q == 2 ? esc[5] : esc[7]) * inv;
            const int lr0 = __hip_atomic_fetch_add(&lcnt[e0], 1, __ATOMIC_RELAXED, __HIP_MEMORY_SCOPE_WORKGROUP), lr1 = __hip_atomic_fetch_add(&lcnt[e1], 1, __ATOMIC_RELAXED, __HIP_MEMORY_SCOPE_WORKGROUP);
            const size_t o = (size_t)t * 8 + 2 * q;
            *(GAS v2u*)(TOKE + o) = (v2u){(unsigned)e0, (unsigned)e1}; *(GAS f32x2*)(TOKW + o) = (f32x2){w0, w1}; *(GAS v2u*)(TOKLR + o) = (v2u){(unsigned)lr0, (unsigned)lr1};
        }
        __syncthreads();
        if (F.tid < 64) CNT[tile * 64 + F.tid] = lcnt[F.tid];
        __syncthreads();
    }
}

__device__ __forceinline__ void assign_phase(Frame& F) {
    const int* CNT = (const int*)(F.ws + TAB_CNT); int* TILEE = (int*)(F.ws + TAB_TILEE); int* META = (int*)(F.ws + TAB_META);
    const int* TOKE = (const int*)(F.ws + WS_TOKE); const float* TOKW = (const float*)(F.ws + WS_TOKW); const int* TOKLR = (const int*)(F.ws + WS_TOKLR);
    int* TOKSLOT = (int*)(F.ws + WS_TOKSLOT); int* ROWTOK = (int*)(F.ws + WS_ROWTOK); float* ROWW = (float*)(F.ws + WS_ROWW);
    LAS int* lpart = (LAS int*)(F.lds); LAS int* ltot = lpart + 512 * 2; LAS int* lbase = ltot + 64; LAS int* lseg = lbase + 64; LAS int* lnt = lseg + 64;
    bool first = true;
    for (int tile = F.vcu; tile < T / 128; tile += F.G) {
        { const int e = F.tid & 63, part = F.tid >> 6; int tot = 0, bs = 0;
#pragma unroll 8
          for (int tt = part * 32; tt < part * 32 + 32; ++tt) { const int c = CNT[tt * 64 + e]; tot += c; bs += (tt < tile) ? c : 0; }
          lpart[(part * 64 + e) * 2] = tot; lpart[(part * 64 + e) * 2 + 1] = bs; }
        __syncthreads();
        if (F.tid < 64) { int tot = 0, bs = 0;
#pragma unroll
            for (int part = 0; part < 8; ++part) { tot += lpart[(part * 64 + F.tid) * 2]; bs += lpart[(part * 64 + F.tid) * 2 + 1]; }
            ltot[F.tid] = tot; lbase[F.tid] = bs; }
        __syncthreads();
        if (F.tid == 0) { int run = 0;
            for (int e = 0; e < NE; ++e) { lseg[e] = run; run += (ltot[e] + 255) & ~255; }
            lnt[0] = run >> 8; }
        __syncthreads();
#pragma unroll
        for (int q = 0; q < 2; ++q) { const int idx = F.tid + q * 512; const size_t tk = (size_t)tile * 1024 + idx; const int e = TOKE[tk];
            const int slot = lseg[e] + lbase[e] + TOKLR[tk];
            TOKSLOT[tk] = slot; ROWTOK[slot] = (int)(tk >> 3); ROWW[slot] = TOKW[tk]; }
        if (first) {
            first = false;
            for (int p = F.vcu; p < NE; p += F.G) { const int seg = lseg[p], tot = ltot[p], pad = (tot + 255) & ~255;
                for (int r = seg + tot + F.tid; r < seg + pad; r += NWAVES * 64) { ROWTOK[r] = 0; ROWW[r] = 0.f; }
                for (int tl = (seg >> 8) + F.tid; tl < ((seg + pad) >> 8); tl += NWAVES * 64) TILEE[tl] = p;
                if (F.tid == 0) { META[MT_ESTART + p] = seg >> 8; META[MT_ECNT + p] = pad >> 8; } }
            if (F.vcu == 0 && F.tid == 0) META[MT_NT] = lnt[0];
            for (int i = F.vcu * (NWAVES * 64) + F.tid; i < T; i += F.G * NWAVES * 64) { ROWTOK[ROUTED_TILES * 256 + i] = i; ROWW[ROUTED_TILES * 256 + i] = 1.0f; }
        }
        __syncthreads();
    }
}

struct Moe1Order {
    const int* tile_e; int nt, G, c;
    __device__ __forceinline__ bool next(int i, pg8::Unit& u) const {
        const int nR = 2 * nt, nU = nR + 2 * SH_TILES; const long Lr = (long)i * G + c; if (Lr >= nU) return false;
        const int L = pg8::xcd_remap((int)Lr, nU);
        int rt, e; const int pn = L & 1;
        if (L < nR) { rt = L >> 1; e = tile_e[rt]; } else { rt = ROUTED_TILES + ((L - nR) >> 1); e = NE; }
        u.pm = rt; u.pn = pn; u.at = rt; u.bt = e * 2 + pn; return true;
    }
    __device__ __forceinline__ int row_tile(int i) const {
        const int nR = 2 * nt, nU = nR + 2 * SH_TILES; const long Lr = (long)i * G + c; if (Lr >= nU) return -1;
        const int L = pg8::xcd_remap((int)Lr, nU); return L < nR ? (L >> 1) : ROUTED_TILES + ((L - nR) >> 1);
    }
};
struct Moe2Order {
    const int* tile_e; int nt, G, c;
    __device__ __forceinline__ bool next(int i, pg8::Unit& u) const {
        const int nU = 4 * nt; const long Lr = (long)i * G + c; if (Lr >= nU) return false;
        const int L = pg8::xcd_remap((int)Lr, nU);
        const int rt = L >> 2, pn = L & 3, e = tile_e[rt];
        u.pm = rt; u.pn = pn; u.at = rt; u.bt = e * 4 + pn; return true;
    }
};

__device__ __forceinline__ void moe2_stationary_phase(Frame& F) {
    const int* META = (const int*)(F.ws + TAB_META);
    const unsigned char* H = F.ws + WS_H; const unsigned char* W2 = F.ws + WS_W2; unsigned char* Y = F.ws + WS_Y;
    int lx = F.lane; asm volatile("" : "+v"(lx));
    const int w = F.wave, fr = lx & 15, fq = lx >> 4, cg = w & 3, rg = w >> 2;
    int f8sa = 0x01010101 * (127 - 5), f8sb = 0x7f7f7f7f; asm volatile("" : "+v"(f8sa), "+v"(f8sb));
    const int aoff = pg8::lds_byte(rg * 64 + fr, fq * 8);
    unsigned voff[2];
#pragma unroll
    for (int i = 0; i < 2; ++i) { int R, C; pg8::stage_rc((w * 64 + lx) * 16 + i * 8192, R, C); voff[i] = (unsigned)(R * 256 + C * 2); }
    const unsigned ldsw = (unsigned)w * 1024u;
#define M2_STAGE(slot, rowbase) do { const unsigned char* g_ = H + (size_t)(rowbase) * 256; _Pragma("unroll") for (int kt_ = 0; kt_ < 2; ++kt_) _Pragma("unroll") for (int i_ = 0; i_ < 2; ++i_) \
        __builtin_amdgcn_global_load_lds((const unsigned*)(g_ + voff[i_] + kt_ * 128), (LAS unsigned*)(F.lds + RING_OFF + (slot) * 32768 + kt_ * 16384 + ldsw + i_ * 8192), 16, 0, 0); } while (0)
    for (int pair = F.vcu; pair < 4 * NE; pair += F.G) {
        const int e = pair >> 2, pn = pair & 3, t0 = META[MT_ESTART + e], ntl = META[MT_ECNT + e], nhp = 2 * ntl;
        if (nhp == 0) continue;
        pg8::i32x8 Bf[4][2];
#pragma unroll
        for (int nf = 0; nf < 4; ++nf)
#pragma unroll
            for (int kt = 0; kt < 2; ++kt) { const unsigned char* bp = W2 + ((size_t)e * D + pn * 256 + cg * 64 + 16 * (fr >> 2) + 4 * nf + (fr & 3)) * FF + kt * 128 + 16 * fq;
                const pg8::i32x4 lo = *(const GAS pg8::i32x4*)bp, hi = *(const GAS pg8::i32x4*)(bp + 64); Bf[nf][kt] = __builtin_shufflevector(lo, hi, 0, 1, 2, 3, 4, 5, 6, 7); }
        asm volatile("s_waitcnt vmcnt(0)" ::: "memory");
        __syncthreads();
        const int rb0 = t0 * 256;
        M2_STAGE(0, rb0); M2_STAGE(1, rb0 + (nhp > 1 ? 128 : 0));
        for (int p = 0; p < nhp; ++p) {
            if (p == 0) asm volatile("s_waitcnt vmcnt(4)" ::: "memory"); else if (p == 1) asm volatile("s_waitcnt vmcnt(8)" ::: "memory"); else asm volatile("s_waitcnt vmcnt(12)" ::: "memory");
            __builtin_amdgcn_s_barrier(); asm volatile("" ::: "memory");
            { const int pnx = (p + 2 < nhp) ? p + 2 : p; M2_STAGE((p + 2) % 3, rb0 + pnx * 128); }
            const int slot = p % 3; const unsigned sb = (unsigned)(RING_OFF + slot * 32768);
            pg8::f32x4 acc[4][4];
#pragma unroll
            for (int kt = 0; kt < 2; ++kt)
#pragma unroll
                for (int m = 0; m < 4; ++m) { pg8::i32x8 Af;
                    { const pg8::i32x4 lo = *(const LAS pg8::i32x4*)(F.lds + sb + kt * 16384 + aoff + m * 2048), hi = *(const LAS pg8::i32x4*)(F.lds + sb + kt * 16384 + aoff + m * 2048 + 1024); Af = __builtin_shufflevector(lo, hi, 0, 1, 2, 3, 4, 5, 6, 7); }
#pragma unroll
                    for (int nf = 0; nf < 4; ++nf) {
                        if (kt == 0) asm volatile("v_mfma_scale_f32_16x16x128_f8f6f4 %0, %1, %2, 0, %3, %4 op_sel_hi:[0,0,0]" : "=&v"(acc[m][nf]) : "v"(Bf[nf][kt]), "v"(Af), "v"(f8sa), "v"(f8sb));
                        else         asm volatile("v_mfma_scale_f32_16x16x128_f8f6f4 %0, %1, %2, %0, %3, %4 op_sel_hi:[0,0,0]" : "+v"(acc[m][nf]) : "v"(Bf[nf][kt]), "v"(Af), "v"(f8sa), "v"(f8sb)); } }
            asm volatile("s_nop 15\n\ts_nop 15" ::: "memory");
            LAS unsigned char* stg = F.lds + RING_OFF + 3 * 32768;
#pragma unroll
            for (int m = 0; m < 4; ++m) { v4u o;
                o.x = pg8::pk4_fp8(acc[m][0][0], acc[m][0][1], acc[m][0][2], acc[m][0][3]); o.y = pg8::pk4_fp8(acc[m][1][0], acc[m][1][1], acc[m][1][2], acc[m][1][3]);
                o.z = pg8::pk4_fp8(acc[m][2][0], acc[m][2][1], acc[m][2][2], acc[m][2][3]); o.w = pg8::pk4_fp8(acc[m][3][0], acc[m][3][1], acc[m][3][2], acc[m][3][3]);
                *(LAS v4u*)(stg + (rg * 64 + 16 * m + fr) * 272 + cg * 64 + 16 * fq) = o; }
            asm volatile("s_waitcnt lgkmcnt(0)" ::: "memory"); __builtin_amdgcn_s_barrier(); asm volatile("" ::: "memory");
            { const size_t rowb = (size_t)rb0 + (size_t)p * 128 + 16 * w;
#pragma unroll
              for (int i = 0; i < 4; ++i) { const int rl = 4 * i + (lx >> 4); const v4u o = *(const LAS v4u*)(stg + (16 * w + rl) * 272 + 16 * (lx & 15));
                  __builtin_nontemporal_store(o, (GAS v4u*)(Y + (rowb + rl) * D + pn * 256 + 16 * (lx & 15))); } }
        }
        asm volatile("s_waitcnt vmcnt(0)" ::: "memory");
        __syncthreads();
    }
#undef M2_STAGE
}

__device__ __forceinline__ void combine_phase(Frame& F) {
    const unsigned char* Y = (const unsigned char*)(F.ws + WS_Y); const int* TOKSLOT = (const int*)(F.ws + WS_TOKSLOT);
    const int gw = F.vcu * NWAVES + F.wave, NGW = F.G * NWAVES;
    f32x4 g4[4], b4[4];
#pragma unroll
    for (int j = 0; j < 4; ++j) { g4[j] = *(const GAS f32x4*)(F.ln2_g + 256 * j + 4 * F.lane); b4[j] = *(const GAS f32x4*)(F.ln2_b + 256 * j + 4 * F.lane); }
#pragma unroll 4
    for (int m = gw; m < T; m += NGW) {
        GAS f32x4* xr = (GAS f32x4*)(F.out + (size_t)m * D) + F.lane;
        unsigned yw[TOPK][4];
#pragma unroll
        for (int k = 0; k < TOPK; ++k) { const int slot = TOKSLOT[(size_t)m * 8 + k]; const GAS unsigned* yr = (const GAS unsigned*)(Y + (size_t)slot * D) + F.lane;
#pragma unroll
            for (int j = 0; j < 4; ++j) yw[k][j] = NTL(yr + 64 * j); }
        f32x4 v[4];
#pragma unroll
        for (int j = 0; j < 4; ++j) { const v2u pw = NTL((const GAS v2u*)((const GAS unsigned char*)(F.out + (size_t)m * D) + 512 * j + 8 * F.lane)); v[j] = (f32x4){blo(pw.x), bhi(pw.x), blo(pw.y), bhi(pw.y)}; }
        f32x4 a[4];
#pragma unroll
        for (int j = 0; j < 4; ++j) a[j] = (f32x4){0.f, 0.f, 0.f, 0.f};
#pragma unroll
        for (int k = 0; k < TOPK; ++k)
#pragma unroll
            for (int j = 0; j < 4; ++j) { const f32x2 lo = __builtin_amdgcn_cvt_pk_f32_fp8((int)yw[k][j], false), hi = __builtin_amdgcn_cvt_pk_f32_fp8((int)yw[k][j], true);
                a[j].x += lo.x; a[j].y += lo.y; a[j].z += hi.x; a[j].w += hi.y; }
        float s = 0.f;
#pragma unroll
        for (int j = 0; j < 4; ++j) { v[j] = v[j] + a[j] * (1.0f / Y_SCALE); s += (v[j].x + v[j].y) + (v[j].z + v[j].w); }
        const float mean = wave_sum(s) * (1.f / D); float s2 = 0.f;
#pragma unroll
        for (int j = 0; j < 4; ++j) { v[j] = v[j] - mean; s2 += (v[j].x * v[j].x + v[j].y * v[j].y) + (v[j].z * v[j].z + v[j].w * v[j].w); }
        const float rstd = 1.f / sqrtf(wave_sum(s2) * (1.f / D) + LN_EPS);
#pragma unroll
        for (int j = 0; j < 4; ++j) xr[64 * j] = v[j] * rstd * g4[j] + b4[j];
    }
}
typedef float f32x16 __attribute__((ext_vector_type(16)));
typedef short s16x8 __attribute__((ext_vector_type(8)));
typedef short s16x4 __attribute__((ext_vector_type(4)));
constexpr int GQ_P = 272, GV_P = 144;
constexpr int G_QT = 0, G_KT = G_QT + 64 * GQ_P, G_KD = G_KT + 64 * GQ_P, G_VT = G_KD + 128 * GV_P, G_AM = G_VT + 256 * GV_P, G_SEG = G_AM + 64 * GV_P,
              G_DL = G_SEG + 8 * 128 * 4, G_WG = G_DL + 512, G_BG = G_WG + 128 * 16 * 4, G_GL = G_BG + 512, G_END = G_GL + 64 * 16 * 4, G_OB = G_QT, G_OBP = 260;
static_assert(G_END <= LDSCTL_OFF && 32 * G_OBP * 4 <= 2 * 64 * GQ_P, "GLA LDS map");
constexpr size_t TAB_DG = WS_TAB + 131072;

template <int MODE>
__device__ __forceinline__ void gla_units(Frame& F) {
    const bf16* QK = (const bf16*)(F.ws + WS_QK); const bf16* VB = (const bf16*)(F.ws + WS_V); const bf16* RB = (const bf16*)(F.ws + WS_R); bf16* OG = (bf16*)(F.ws + WS_OG);
    const float* GLR = (const float*)(F.ws + WS_GLR); float* LS = (float*)(F.ws + WS_L); float* DG = (float*)(F.ws + TAB_DG);
    LAS unsigned char* L = F.lds; bf16* GLG = (bf16*)F.out;
    const int lane = F.lane, w = F.wave, ig = w;
    const f32x4 gn = *(const GAS f32x4*)(F.gla_norm_g + 4 * lane);
#define GLA_LANE() int lx_ = lane; asm volatile("" : "+v"(lx_)); const int hh = lx_ >> 5, ln = lx_ & 31, d0 = 2 * lx_; (void)hh; (void)ln; (void)d0
    for (int u = F.vcu; u < 256; u += F.G) {
        const int b = u >> 7, h = (u >> 5) & 3, grp = u & 31; const size_t tok0 = (size_t)b * SEQ + (size_t)grp * 512;
        __syncthreads();
        if (MODE == 0 && F.tid < 128) { const int d = F.tid;
#pragma unroll
            for (int r = 0; r < GRANK; ++r) *(LAS float*)(L + G_WG + (r * 128 + d) * 4) = F.w_gate_up[r * 512 + h * 128 + d];
            *(LAS float*)(L + G_BG + d * 4) = F.b_gate[h * 128 + d]; }
        f32x16 S[4];
        if (MODE == 0) {
#pragma unroll
            for (int t = 0; t < 4; ++t)
#pragma unroll
                for (int r = 0; r < 16; ++r) S[t][r] = 0.f;
        } else {
#pragma unroll
            for (int t = 0; t < 4; ++t)
#pragma unroll
                for (int rp = 0; rp < 8; ++rp) { const unsigned wd = ((const unsigned*)LS)[(size_t)u * 16384 + ((w * 4 + t) * 8 + rp) * 64 + lane]; S[t][2 * rp] = blo(wd); S[t][2 * rp + 1] = bhi(wd); }
        }
        f32x2 gsum = (f32x2){0.f, 0.f};
        unsigned qraw[8], kraw[8], vraw[2][8], graw[8]; f32x2 glq = (f32x2){0.f, 0.f}; v2u rraw[2][4];
#define GLA_LOADR(c) do { const size_t t0_ = tok0 + 64 * (c); GLA_LANE(); _Pragma("unroll") for (int rt_ = 0; rt_ < 2; ++rt_) _Pragma("unroll") for (int q_ = 0; q_ < 4; ++q_) \
            rraw[rt_][q_] = *(const GAS v2u*)(RB + (t0_ + 32 * rt_ + 4 * w + q_) * 1024 + h * 256 + 4 * lx_); } while (0)
#define GLA_LOAD(c) do { const size_t t0_ = tok0 + 64 * (c); GLA_LANE(); const int tid_ = w * 64 + lx_; \
            _Pragma("unroll") for (int i = 0; i < 8; ++i) { const size_t tk = t0_ + 8 * ig + i; kraw[i] = *(const GAS unsigned*)(QK + tk * 1024 + 512 + h * 128 + d0); \
                if (MODE == 1) { qraw[i] = *(const GAS unsigned*)(QK + tk * 1024 + h * 128 + d0); graw[i] = *(const GAS unsigned*)(GLG + tk * 512 + h * 128 + d0); } } \
            if (MODE == 0) glq = *(const GAS f32x2*)(GLR + t0_ * GRANK + 2 * tid_); \
            _Pragma("unroll") for (int q = 0; q < 2; ++q) { const int id = tid_ + 512 * q, dvp = id & 127, tg = id >> 7; \
                _Pragma("unroll") for (int i = 0; i < 8; ++i) vraw[q][i] = *(const GAS unsigned*)(VB + (t0_ + 8 * tg + i) * 1024 + h * 256 + 2 * dvp); } } while (0)
        GLA_LOAD(0);
        if (MODE == 1) GLA_LOADR(0);
        if (MODE == 0) *(LAS f32x2*)(L + G_GL + F.tid * 8) = glq;
        __syncthreads();
        for (int c = 0; c < 8; ++c) {
            const size_t t0 = tok0 + 64 * c;
            f32x2 cs[8];
            {
                GLA_LANE();
                f32x2 run = (f32x2){0.f, 0.f};
                if (MODE == 0) {
                    f32x2 wg[GRANK];
#pragma unroll
                    for (int r = 0; r < GRANK; ++r) wg[r] = *(const LAS f32x2*)(L + G_WG + (r * 128 + d0) * 4);
                    const f32x2 bgv = *(const LAS f32x2*)(L + G_BG + d0 * 4);
#pragma unroll
                    for (int i = 0; i < 8; ++i) {
                        f32x2 z = bgv;
#pragma unroll
                        for (int q = 0; q < 4; ++q) { const f32x4 g4 = *(const LAS f32x4*)(L + G_GL + ((8 * ig + i) * 16 + 4 * q) * 4);
                            z += wg[4 * q] * g4.x; z += wg[4 * q + 1] * g4.y; z += wg[4 * q + 2] * g4.z; z += wg[4 * q + 3] * g4.w; }
                        const float l0 = (fminf(z.x, 0.f) - __logf(1.0f + __expf(-fabsf(z.x)))) * (1.0f / 16.0f), l1 = (fminf(z.y, 0.f) - __logf(1.0f + __expf(-fabsf(z.y)))) * (1.0f / 16.0f);
                        const unsigned gp = cvtpk(l0, l1);
                        *(GAS unsigned*)(GLG + (t0 + 8 * ig + i) * 512 + h * 128 + d0) = gp;
                        run += (f32x2){blo(gp), bhi(gp)}; cs[i] = run;
                    }
                } else {
#pragma unroll
                    for (int i = 0; i < 8; ++i) { run += (f32x2){blo(graw[i]), bhi(graw[i])}; cs[i] = run; }
                }
                *(LAS f32x2*)(L + G_SEG + (ig * 128 + d0) * 4) = run;
            }
            { GLA_LANE(); const int tid_ = w * 64 + lx_;
#pragma unroll
            for (int q = 0; q < 2; ++q) { const int id = tid_ + 512 * q, dvp = id & 127, tg = id >> 7;
                v4u lo, hi;
                lo.x = (vraw[q][0] & 0xffffu) | (vraw[q][1] << 16); lo.y = (vraw[q][2] & 0xffffu) | (vraw[q][3] << 16); lo.z = (vraw[q][4] & 0xffffu) | (vraw[q][5] << 16); lo.w = (vraw[q][6] & 0xffffu) | (vraw[q][7] << 16);
                hi.x = (vraw[q][0] >> 16) | (vraw[q][1] & 0xffff0000u); hi.y = (vraw[q][2] >> 16) | (vraw[q][3] & 0xffff0000u); hi.z = (vraw[q][4] >> 16) | (vraw[q][5] & 0xffff0000u); hi.w = (vraw[q][6] >> 16) | (vraw[q][7] & 0xffff0000u);
                *(LAS v4u*)(L + G_VT + (2 * dvp) * GV_P + tg * 16) = lo; *(LAS v4u*)(L + G_VT + (2 * dvp + 1) * GV_P + tg * 16) = hi; } }
            LDS_BARRIER();
            {
                GLA_LANE();
                f32x2 pre = (f32x2){0.f, 0.f}, tot = (f32x2){0.f, 0.f};
#pragma unroll
                for (int s = 0; s < 8; ++s) { const f32x2 sv = *(const LAS f32x2*)(L + G_SEG + (s * 128 + d0) * 4); tot += sv; if (s < ig) pre += sv; }
                const f32x2 dl = (f32x2){__expf(tot.x), __expf(tot.y)};
                if (ig == 0) *(LAS f32x2*)(L + G_DL + d0 * 4) = dl;
                gsum += tot;
                f32x2 kd[8];
#pragma unroll
                for (int i = 0; i < 8; ++i) {
                    const f32x2 bb = pre + cs[i];
                    const f32x2 kk = (f32x2){blo(kraw[i]), bhi(kraw[i])};
                    if (MODE == 1) {
                        const f32x2 kt = kk * (f32x2){__expf(-bb.x), __expf(-bb.y)};
                        const f32x2 qq = (f32x2){blo(qraw[i]), bhi(qraw[i])} * (f32x2){__expf(bb.x), __expf(bb.y)};
                        *(LAS unsigned*)(L + G_QT + (8 * ig + i) * GQ_P + d0 * 2) = cvtpk(qq.x, qq.y);
                        *(LAS unsigned*)(L + G_KT + (8 * ig + i) * GQ_P + d0 * 2) = cvtpk(kt.x, kt.y);
                        kd[i] = kt * dl;
                    } else { kd[i] = kk * (f32x2){__expf(tot.x - bb.x), __expf(tot.y - bb.y)}; }
                }
                v4u p0, p1;
                p0.x = cvtpk(kd[0].x, kd[1].x); p0.y = cvtpk(kd[2].x, kd[3].x); p0.z = cvtpk(kd[4].x, kd[5].x); p0.w = cvtpk(kd[6].x, kd[7].x);
                p1.x = cvtpk(kd[0].y, kd[1].y); p1.y = cvtpk(kd[2].y, kd[3].y); p1.z = cvtpk(kd[4].y, kd[5].y); p1.w = cvtpk(kd[6].y, kd[7].y);
                *(LAS v4u*)(L + G_KD + d0 * GV_P + ig * 16) = p0; *(LAS v4u*)(L + G_KD + (d0 + 1) * GV_P + ig * 16) = p1;
            }
            if (c < 7) GLA_LOAD(c + 1);
            LDS_BARRIER();
            f32x16 o[2];
            if (MODE == 1) {
                GLA_LANE();
#pragma unroll
                for (int tt = 0; tt < 2; ++tt) { const int id = 2 * w + tt, ti = id >> 2, tj = id & 3, r16 = lx_ & 15, kg = lx_ >> 4;
                    f32x4 sc = (f32x4){0.f, 0.f, 0.f, 0.f};
#pragma unroll
                    for (int ks = 0; ks < 4; ++ks) { const s16x8 ka = *(const LAS s16x8*)(L + G_KT + (16 * tj + r16) * GQ_P + (32 * ks + 8 * kg) * 2), qb = *(const LAS s16x8*)(L + G_QT + (16 * ti + r16) * GQ_P + (32 * ks + 8 * kg) * 2);
                        sc = __builtin_amdgcn_mfma_f32_16x16x32_bf16(ka, qb, sc, 0, 0, 0); }
                    const int i = 16 * ti + r16, j0 = 16 * tj + 4 * kg;
                    v2u pw; pw.x = cvtpk(j0 <= i ? sc[0] : 0.f, j0 + 1 <= i ? sc[1] : 0.f); pw.y = cvtpk(j0 + 2 <= i ? sc[2] : 0.f, j0 + 3 <= i ? sc[3] : 0.f);
                    *(LAS v2u*)(L + G_AM + i * GV_P + j0 * 2) = pw; }
                __builtin_amdgcn_sched_barrier(0);
#pragma unroll
                for (int rt = 0; rt < 2; ++rt)
#pragma unroll
                    for (int r = 0; r < 16; ++r) o[rt][r] = 0.f;
#pragma unroll
                for (int t = 0; t < 4; ++t)
#pragma unroll
                    for (int s = 0; s < 2; ++s) {
                        v4u pb; pb.x = cvtpk(S[t][8 * s], S[t][8 * s + 1]); pb.y = cvtpk(S[t][8 * s + 2], S[t][8 * s + 3]); pb.z = cvtpk(S[t][8 * s + 4], S[t][8 * s + 5]); pb.w = cvtpk(S[t][8 * s + 6], S[t][8 * s + 7]);
                        const s16x8 bfrag = __builtin_bit_cast(s16x8, pb);
#pragma unroll
                        for (int rt = 0; rt < 2; ++rt) { const int dk = 32 * t + 16 * s + 4 * hh;
                            const v2u a0 = *(const LAS v2u*)(L + G_QT + (32 * rt + ln) * GQ_P + dk * 2), a1 = *(const LAS v2u*)(L + G_QT + (32 * rt + ln) * GQ_P + (dk + 8) * 2);
                            const v4u av = (v4u){a0.x, a0.y, a1.x, a1.y};
                            o[rt] = __builtin_amdgcn_mfma_f32_32x32x16_bf16(__builtin_bit_cast(s16x8, av), bfrag, o[rt], 0, 0, 0); }
                        __builtin_amdgcn_sched_barrier(0);
                    }
                LDS_BARRIER();
            }
            {
                GLA_LANE();
                s16x8 vf[4];
#pragma unroll
                for (int s = 0; s < 4; ++s) vf[s] = *(const LAS s16x8*)(L + G_VT + (32 * w + ln) * GV_P + (16 * s + 8 * hh) * 2);
                if (MODE == 1) {
#pragma unroll
                    for (int s = 0; s < 4; ++s)
#pragma unroll
                        for (int rt = 0; rt < 2; ++rt) { if (rt == 0 && s >= 2) continue;
                            const s16x8 af = *(const LAS s16x8*)(L + G_AM + (32 * rt + ln) * GV_P + (16 * s + 8 * hh) * 2);
                            o[rt] = __builtin_amdgcn_mfma_f32_32x32x16_bf16(af, vf[s], o[rt], 0, 0, 0); }
                }
#pragma unroll
                for (int t = 0; t < 4; ++t) {
#pragma unroll
                    for (int g = 0; g < 4; ++g) { const f32x4 dv4 = *(const LAS f32x4*)(L + G_DL + (32 * t + 8 * g + 4 * hh) * 4);
                        S[t][4 * g] *= dv4.x; S[t][4 * g + 1] *= dv4.y; S[t][4 * g + 2] *= dv4.z; S[t][4 * g + 3] *= dv4.w; }
#pragma unroll
                    for (int s = 0; s < 4; ++s) { const s16x8 af = *(const LAS s16x8*)(L + G_KD + (32 * t + ln) * GV_P + (16 * s + 8 * hh) * 2);
                        S[t] = __builtin_amdgcn_mfma_f32_32x32x16_bf16(af, vf[s], S[t], 0, 0, 0); }
                    __builtin_amdgcn_sched_barrier(0);
                }
            }
            if (MODE == 0) { if (c < 7) *(LAS f32x2*)(L + G_GL + F.tid * 8) = glq; LDS_BARRIER(); }
            else {
#pragma unroll
                for (int rt = 0; rt < 2; ++rt) {
                    GLA_LANE();
                    if (rt == 1) LDS_BARRIER();
#pragma unroll
                    for (int r = 0; r < 16; ++r) *(LAS float*)(L + G_OB + (((r & 3) + 8 * (r >> 2) + 4 * hh) * G_OBP + 32 * w + ln) * 4) = o[rt][r];
                    LDS_BARRIER();
#pragma unroll
                    for (int q = 0; q < 4; ++q) { const int tl = 4 * w + q;
                        const f32x4 ov = *(const LAS f32x4*)(L + G_OB + (tl * G_OBP + 4 * lx_) * 4);
                        const float ss = wave_sum(ov.x * ov.x + ov.y * ov.y + ov.z * ov.z + ov.w * ov.w), rinv = __builtin_amdgcn_rsqf(ss * (1.0f / 256.0f) + RMS_EPS);
                        const float r0 = blo(rraw[rt][q].x), r1 = bhi(rraw[rt][q].x), r2 = blo(rraw[rt][q].y), r3 = bhi(rraw[rt][q].y);
                        v2u ow; ow.x = cvtpk(ov.x * rinv * gn.x * (r0 * pg8::sigm(r0)), ov.y * rinv * gn.y * (r1 * pg8::sigm(r1))); ow.y = cvtpk(ov.z * rinv * gn.z * (r2 * pg8::sigm(r2)), ov.w * rinv * gn.w * (r3 * pg8::sigm(r3)));
                        *(GAS v2u*)(OG + (t0 + 32 * rt + tl) * 1024 + h * 256 + 4 * lx_) = ow; }
                }
                if (c < 7) GLA_LOADR(c + 1);
            }
        }
#undef GLA_LOAD
#undef GLA_LOADR
        if (MODE == 0) {
#pragma unroll
            for (int t = 0; t < 4; ++t)
#pragma unroll
                for (int rp = 0; rp < 8; ++rp) ((unsigned*)LS)[(size_t)u * 16384 + ((w * 4 + t) * 8 + rp) * 64 + lane] = cvtpk(S[t][2 * rp], S[t][2 * rp + 1]);
            if (ig == 0) *(GAS f32x2*)(DG + (size_t)u * 128 + 2 * lane) = (f32x2){__expf(gsum.x), __expf(gsum.y)};
        }
    }
}
#undef GLA_LANE
__device__ __forceinline__ void gla_scan_phase(Frame& F) {
    unsigned* LSW = (unsigned*)(F.ws + WS_L); const float* DG = (const float*)(F.ws + TAB_DG);
    const int gt = F.vcu * (NWAVES * 64) + F.tid, NT = F.G * NWAVES * 64;
    for (int idx = gt; idx < 8 * 16384; idx += NT) {
        const int bh = idx >> 14, e = idx & 16383, l = e & 63, rp = (e >> 6) & 7, t = (e >> 9) & 3, r0 = 2 * rp, dk = 32 * t + (r0 & 3) + 8 * (r0 >> 2) + 4 * (l >> 5);
        float s0 = 0.f, s1 = 0.f;
#pragma unroll 8
        for (int j = 0; j < 32; ++j) { const size_t a = (size_t)(bh * 32 + j) * 16384 + e; const unsigned lv = LSW[a]; LSW[a] = cvtpk(s0, s1);
            const f32x2 dg = *(const f32x2*)(DG + (bh * 32 + j) * 128 + dk); s0 = dg.x * s0 + blo(lv); s1 = dg.y * s1 + bhi(lv); }
    }
}
constexpr int NPH = 12;
struct Args { const float* in[22]; float* out; unsigned char* ws; int ph_lo, ph_hi, li, pad; };
__global__ void __launch_bounds__(NWAVES * 64, 2) fwd(Args args) {
    extern __shared__ __attribute__((aligned(16))) unsigned char lds[];
    Frame F;
    F.lds = (LAS unsigned char*)lds;
    F.MISC = (volatile LAS unsigned*)(F.lds + MISC_OFF);
    F.tid = threadIdx.x; F.lane = F.tid & 63; F.wave = __builtin_amdgcn_readfirstlane(F.tid >> 6);
    F.G = gridDim.x; { const int bx = blockIdx.x; F.vcu = (F.G % 8 == 0) ? (bx % 8) * (F.G / 8) + bx / 8 : bx; }
    F.ws = args.ws; F.ctl = (gu32*)(args.ws + WS_CTL); F.out = args.out;
    F.x = args.in[0]; F.w_in = args.in[1]; F.w_gate_up = args.in[2]; F.b_gate = args.in[3]; F.gla_norm_g = args.in[4]; F.w_gla_up = args.in[5]; F.w_pool_grp = args.in[6];
    F.pool_scale = args.in[7]; F.w_pool_up = args.in[8]; F.w_out = args.in[9]; F.ln1_g = args.in[10]; F.ln1_b = args.in[11]; F.w_router = args.in[12]; F.router_bias = args.in[13];
    F.w_exp_gate = args.in[14]; F.w_exp_up = args.in[15]; F.w_exp_down = args.in[16]; F.w_sh_gate = args.in[17]; F.w_sh_up = args.in[18]; F.w_sh_down = args.in[19]; F.ln2_g = args.in[20]; F.ln2_b = args.in[21];
    for (int u = F.tid; u < (LDS_BYTES - LDSCTL_OFF) / 4; u += NWAVES * 64) ((LAS unsigned*)(F.lds + LDSCTL_OFF))[u] = 0u;
    __syncthreads();
    XcdBarrier bar; bar.bar = (unsigned*)(F.ctl + CW_BAR); bar.x = 0; bar.st = nullptr;
    if (MK_FUSED) bar = xcd_barrier_post((unsigned*)(F.ctl + CW_BAR), F.MISC + 8);
#define GRID_BAR() do { if (MK_FUSED) xcd_barrier(bar); } while (0)
    const int lo = args.ph_lo, hi = args.ph_hi;
#ifdef PHASE_ONLY
#define IN(k) ((k) == PHASE_ONLY && lo <= (k) && (k) < hi)
#else
#define IN(k) (lo <= (k) && (k) < hi)
#endif
#define BOTH(k) (IN(k) && IN((k) + 1))
    const PG8_LAS int* idxtab = (const PG8_LAS int*)(F.lds + IDX_OFF);
    bf16* const QK = (bf16*)(F.ws + WS_QK); bf16* const VB = (bf16*)(F.ws + WS_V); bf16* const RB = (bf16*)(F.ws + WS_R); bf16* const UB = (bf16*)(F.ws + WS_U);
    bf16* const GA = (bf16*)(F.ws + WS_GA); bf16* const GB = (bf16*)(F.ws + WS_GB);

    if (IN(0)) { p0_prologue(F); if (BOTH(0)) GRID_BAR(); }
    if (IN(1)) { {
        pg8::StaticOrder S; S.init(T, NPROJ, F.G, (int)blockIdx.x);
        pg8::EpiProj E{QK, VB, RB, UB, GA, GB};
        pg8::gemm_phase<pg8::EpiProj, pg8::StaticOrder, PG8_ALIGN, PG8_SP2, false>(F.lds + RING_OFF, (const bf16*)(F.ws + WS_XB), (const bf16*)(F.ws + WS_WIN), D, S, E, idxtab); }
        if (BOTH(1)) GRID_BAR();
    }
    if (IN(2)) { pool_phase(F); gla_units<0>(F); if (BOTH(2)) GRID_BAR(); }
    if (IN(3)) { gla_scan_phase(F); if (BOTH(3)) GRID_BAR(); }
    if (IN(4)) { gla_units<1>(F); if (BOTH(4)) GRID_BAR(); }
    if (IN(5)) { {
        pg8::StaticOrder S; S.init(T, D, F.G, (int)blockIdx.x);
        { pg8::EpiGate<0> E{GA, nullptr, (bf16*)(F.ws + WS_T1)};
          pg8::gemm_phase<pg8::EpiGate<0>, pg8::StaticOrder, PG8_ALIGN, PG8_SP2, false>(F.lds + RING_OFF, (const bf16*)(F.ws + WS_OG), (const bf16*)(F.ws + WS_WGLA), D, S, E, idxtab); }
        { pg8::EpiGate<1> E{GB, (const bf16*)(F.ws + WS_T1), (bf16*)(F.ws + WS_MG)};
          pg8::gemm_phase<pg8::EpiGate<1>, pg8::StaticOrder, PG8_ALIGN, PG8_SP2, false>(F.lds + RING_OFF, (const bf16*)(F.ws + WS_PO), (const bf16*)(F.ws + WS_WPC), PW, S, E, idxtab); } }
        if (BOTH(5)) GRID_BAR();
    }
    if (IN(6)) { {
        pg8::StaticOrder S; S.init(T, D, F.G, (int)blockIdx.x);
        pg8::EpiPre1 E{F.x, (bf16*)F.out, DN_ALPHA, (float*)(F.ws + WS_PST)};
        pg8::gemm_phase<pg8::EpiPre1, pg8::StaticOrder, PG8_ALIGN, PG8_SP2, false>(F.lds + RING_OFF, (const bf16*)(F.ws + WS_MG), (const bf16*)(F.ws + WS_WOUT), D, S, E, idxtab); }
        if (BOTH(6)) GRID_BAR();
    }
    if (IN(7)) { router_phase(F); expert_w1_phase(F); if (BOTH(7)) GRID_BAR(); }
    if (IN(8)) { assign_phase(F); if (BOTH(8)) GRID_BAR(); }
    const int* TILEE = (const int*)(F.ws + TAB_TILEE); const int* META = (const int*)(F.ws + TAB_META);
    if (IN(9)) { {
        Moe1Order S{TILEE, META[MT_NT], F.G, (int)blockIdx.x};
        { const int* ROWTOK = (const int*)(F.ws + WS_ROWTOK); LAS int* it = (LAS int*)(F.lds + IDX_OFF);
          int rowv[IDX_UNITS];
#pragma unroll
          for (int i = 0; i < IDX_UNITS; ++i) { const int rt = S.row_tile(i); rowv[i] = (rt >= 0 && F.tid < 256) ? ROWTOK[rt * 256 + F.tid] : 0; }
#pragma unroll
          for (int i = 0; i < IDX_UNITS; ++i) if (F.tid < 256) it[i * 256 + F.tid] = rowv[i];
          __syncthreads(); }
        pg8::EpiMoe1F8 E{F.ws + WS_H, (const float*)(F.ws + WS_ROWW)};
        pg8::gemm_phase<pg8::EpiMoe1F8, Moe1Order, PG8_ALIGN, PG8_SP2, true, true, -5>(F.lds + RING_OFF, (const bf16*)(F.ws + WS_H1F), (const bf16*)(F.ws + WS_W1), D / 2, S, E, idxtab); }
        expert_w2_phase(F);
        if (BOTH(9)) GRID_BAR();
    }
    if (IN(10)) {
        { pg8::StaticOrder S; S.init(T, D, F.G, (int)blockIdx.x);
          pg8::EpiPre2 E{(bf16*)F.out, (const float*)(F.ws + TAB_STATS), F.ln1_g, F.ln1_b, DN_ALPHA, 1.0f};
          pg8::gemm_phase<pg8::EpiPre2, pg8::StaticOrder, PG8_ALIGN, PG8_SP2, false, true, -9>(F.lds + RING_OFF, (const bf16*)(F.ws + WS_H + (size_t)ROUTED_TILES * 256 * FF), (const bf16*)(F.ws + WS_W2 + (size_t)NE * D * FF), FF / 2, S, E, idxtab); }
#ifdef MOE2_PG8
        { Moe2Order S{TILEE, META[MT_NT], F.G, (int)blockIdx.x};
          pg8::EpiFp8 E{(unsigned char*)(F.ws + WS_Y), D, 1.0f};
          pg8::gemm_phase<pg8::EpiFp8, Moe2Order, PG8_ALIGN, PG8_SP2, false, true, -5>(F.lds + RING_OFF, (const bf16*)(F.ws + WS_H), (const bf16*)(F.ws + WS_W2), FF / 2, S, E, idxtab); }
#else
        moe2_stationary_phase(F);
#endif
        if (BOTH(10)) GRID_BAR();
    }
    if (IN(11)) { combine_phase(F); }
#undef IN
#undef BOTH
}

extern "C" void kernel_launch(void* const* d_in, const int* in_sizes, int n_in, void* d_out, int out_size, void* d_ws, size_t ws_size, hipStream_t stream) {
    static int grid = 0;
    if (grid == 0) {
        if (n_in != 22 || in_sizes[0] != T * D || out_size != T * D || ws_size < WS_END) { fprintf(stderr, "kernel_launch: built for 22 inputs, x/out of %d floats, >= %zu bytes of workspace; got n_in %d, in0 %d, out %d, ws %zu; nothing launched\n", T * D, (size_t)WS_END, n_in, n_in > 0 ? in_sizes[0] : -1, out_size, ws_size); grid = -1; return; }
        int dev = 0, cus = 0, per_cu = 0;
        if (hipGetDevice(&dev) != hipSuccess || hipDeviceGetAttribute(&cus, hipDeviceAttributeMultiprocessorCount, dev) != hipSuccess) { fprintf(stderr, "kernel_launch: device query failed\n"); grid = -1; return; }
        if (hipFuncSetAttribute((const void*)fwd, hipFuncAttributeMaxDynamicSharedMemorySize, LDS_BYTES) != hipSuccess) { fprintf(stderr, "kernel_launch: hipFuncSetAttribute failed\n"); grid = -1; return; }
        if (hipOccupancyMaxActiveBlocksPerMultiprocessor(&per_cu, (const void*)fwd, NWAVES * 64, LDS_BYTES) != hipSuccess || per_cu < 1)
            fprintf(stderr, "kernel_launch: note: occupancy query reports %d workgroups per CU\n", per_cu);
        (void)hipGetLastError();
        grid = cus;
        if (grid > 256) grid = 256;
    }
    if (grid < 0) return;
    if (hipMemsetAsync((char*)d_ws + WS_CTL, 0, CTL_ZERO_BYTES, stream) != hipSuccess) { fprintf(stderr, "kernel_launch: memset failed\n"); return; }
    Args a{};
    for (int i = 0; i < 22; ++i) a.in[i] = (const float*)d_in[i];
    a.out = (float*)d_out; a.ws = (unsigned char*)d_ws;
#if MK_FUSED
    a.ph_lo = 0; a.ph_hi = NPH; a.li = 0;
    hipLaunchKernelGGL(fwd, dim3(grid), dim3(NWAVES * 64), LDS_BYTES, stream, a);
#else
    for (int li = 0; li < NPH; ++li) { a.ph_lo = li; a.ph_hi = li + 1; a.li = li; hipLaunchKernelGGL(fwd, dim3(grid), dim3(NWAVES * 64), LDS_BYTES, stream, a); }
#endif
    const hipError_t le = hipPeekAtLastError();
    if (le != hipSuccess) fprintf(stderr, "kernel_launch: launch failed: %s\n", hipGetErrorName(le));
}
```

```cpp
#include <hip/hip_runtime.h>
#include <cstdio>
#include <cstdint>
#include <cmath>
#define MK_FUSED 1
#define NT_LOADS 1
#ifdef NT_LOADS
#define NTL(p_) __builtin_nontemporal_load(p_)
#else
#define NTL(p_) (*(p_))
#endif
namespace pg8 {
#define PG8_LAS __attribute__((address_space(3)))
typedef unsigned short bf16_t;
typedef short bf16x8 __attribute__((ext_vector_type(8)));
typedef float f32x4 __attribute__((ext_vector_type(4)));
typedef float f32x2 __attribute__((ext_vector_type(2)));
typedef unsigned u32x4 __attribute__((ext_vector_type(4)));
typedef unsigned u32x2 __attribute__((ext_vector_type(2)));
typedef int i32x4 __attribute__((ext_vector_type(4)));
typedef int i32x8 __attribute__((ext_vector_type(8)));
constexpr int BM = 256, BK = 64, HALF = 128, HTB = HALF * BK * 2  , STAGE_BYTES = 8 * HTB, NXCD = 8, WGM = 4;

__host__ __device__ __forceinline__ int lds_byte(int r, int c) { const int st = (r >> 4) * 2 + (c >> 5), rr = r & 15, cc = c & 31, ob = rr * 64 + cc * 2; return st * 1024 + (ob ^ (((ob >> 9) & 1) << 5)); }
__host__ __device__ __forceinline__ void stage_rc(int b, int& R, int& C) { const int st = b / 1024, sb = b % 1024, swz = sb ^ (((sb >> 9) & 1) << 5); R = (st >> 1) * 16 + swz / 64; C = (st & 1) * 32 + (swz % 64) / 2; }
__host__ __device__ __forceinline__ int perm32(int rho) { const int n = rho >> 4, i = rho & 15; return 8 * (i >> 2) + 4 * n + (i & 3); }

struct Unit { int pm, pn, at, bt; };

__host__ __device__ __forceinline__ int xcd_remap(int wgid, int nwg) { const int q = nwg / NXCD, r = nwg % NXCD, xcd = wgid % NXCD, off = wgid / NXCD; return (xcd < r ? xcd * (q + 1) : r * (q + 1) + (xcd - r) * q) + off; }

struct StaticOrder {
    int nM, nN, nwg, G, c;
    __host__ __device__ void init(int M, int N, int G_, int c_) { nM = M / BM; nN = N / BM; nwg = nM * nN; G = G_; c = c_; }
    __host__ __device__ bool next(int i, Unit& u) const {
        const long L = (long)i * G + c; if (L >= nwg) return false;
        const int wgid = xcd_remap((int)L, nwg);
        const int nig = WGM * nN, gid = wgid / nig, fm = gid * WGM, gsz = (nM - fm) < WGM ? (nM - fm) : WGM;
        u.pm = fm + ((wgid % nig) % gsz); u.pn = (wgid % nig) / gsz; u.at = u.pm; u.bt = u.pn; return true;
    }
};

__device__ __forceinline__ unsigned cvt_pk_bf16(float lo, float hi) { unsigned r; asm volatile("v_cvt_pk_bf16_f32 %0, %1, %2" : "=v"(r) : "v"(lo), "v"(hi)); return r; }
__device__ __forceinline__ float bflo(unsigned w) { return __uint_as_float(w << 16); }
__device__ __forceinline__ float bfhi(unsigned w) { return __uint_as_float(w & 0xffff0000u); }
__device__ __forceinline__ float sigm(float x) { return __builtin_amdgcn_rcpf(1.0f + __expf(-x)); }
__device__ __forceinline__ u32x4 pack8(const f32x4& v0, const f32x4& v1) { u32x4 w; w.x = cvt_pk_bf16(v0[0], v0[1]); w.y = cvt_pk_bf16(v0[2], v0[3]); w.z = cvt_pk_bf16(v1[0], v1[1]); w.w = cvt_pk_bf16(v1[2], v1[3]); return w; }
__device__ __forceinline__ void unpack8(const u32x4& w, f32x4& v0, f32x4& v1) { v0 = (f32x4){bflo(w.x), bfhi(w.x), bflo(w.y), bfhi(w.y)}; v1 = (f32x4){bflo(w.z), bfhi(w.z), bflo(w.w), bfhi(w.w)}; }

struct EpiBf16 {
    static constexpr bool PERM = true;
    bf16_t* O; int ldc;
    __device__ __forceinline__ void operator()(const f32x4 (&acc)[2][2][4][2], const Unit& u, int wr, int wc, int fr, int fq) const {
        const int row0 = u.pm * BM + wr * 64 + fr, col0 = u.pn * BM + wc * 32 + 8 * fq;
#pragma unroll
        for (int ai = 0; ai < 2; ++ai)
#pragma unroll
            for (int m = 0; m < 4; ++m) { bf16_t* rowp = O + (size_t)(row0 + ai * HALF + m * 16) * ldc + col0;
#pragma unroll
                for (int bj = 0; bj < 2; ++bj) *(u32x4*)(rowp + bj * HALF) = pack8(acc[ai][bj][m][0], acc[ai][bj][m][1]); }
    }
};
__device__ __forceinline__ unsigned pk4_fp8(float a, float b, float c, float d) {
    int p = 0; p = __builtin_amdgcn_cvt_pk_fp8_f32(__builtin_amdgcn_fmed3f(a, -440.f, 440.f), __builtin_amdgcn_fmed3f(b, -440.f, 440.f), p, false);
    p = __builtin_amdgcn_cvt_pk_fp8_f32(__builtin_amdgcn_fmed3f(c, -440.f, 440.f), __builtin_amdgcn_fmed3f(d, -440.f, 440.f), p, true); return (unsigned)p; }
struct EpiMoe1F8 {
    static constexpr bool PERM = true;
    unsigned char* H; const float* RW;
    __device__ __forceinline__ void operator()(const f32x4 (&acc)[2][2][4][2], const Unit& u, int wr, int wc, int fr, int fq) const {
        const int row0 = u.pm * BM + wr * 64 + fr, col0 = u.pn * HALF + wc * 32 + 8 * fq;
#pragma unroll
        for (int ai = 0; ai < 2; ++ai)
#pragma unroll
            for (int m = 0; m < 4; ++m) { const int row = row0 + ai * HALF + m * 16; const float w = RW[row] * 16.0f;
                float v[8];
#pragma unroll
                for (int j = 0; j < 4; ++j) { const float g0 = acc[ai][0][m][0][j], g1 = acc[ai][0][m][1][j];
                    v[j] = g0 * sigm(g0) * acc[ai][1][m][0][j] * w; v[4 + j] = g1 * sigm(g1) * acc[ai][1][m][1][j] * w; }
                *(u32x2*)(H + (size_t)row * 256 + col0) = (u32x2){pk4_fp8(v[0], v[1], v[2], v[3]), pk4_fp8(v[4], v[5], v[6], v[7])}; }
    }
};
struct EpiFp8 {
    static constexpr int PERM = 2;
    unsigned char* O; int ldc; float scale;
    __device__ __forceinline__ void operator()(const f32x4 (&acc)[2][2][4][2], const Unit& u, int wr, int wc, int fr, int fq) const {
        const int row0 = u.pm * BM + wr * 64 + fr, col0 = u.pn * BM + wc * 64 + 16 * fq;
#pragma unroll
        for (int ai = 0; ai < 2; ++ai)
#pragma unroll
            for (int m = 0; m < 4; ++m) { unsigned char* rowp = O + (size_t)(row0 + ai * HALF + m * 16) * ldc + col0; u32x4 w;
#pragma unroll
                for (int bj = 0; bj < 2; ++bj)
#pragma unroll
                    for (int n = 0; n < 2; ++n) { const f32x4 v = (scale == 1.0f) ? acc[ai][bj][m][n] : acc[ai][bj][m][n] * scale; int p = 0;
                        p = __builtin_amdgcn_cvt_pk_fp8_f32(v[0], v[1], p, false); p = __builtin_amdgcn_cvt_pk_fp8_f32(v[2], v[3], p, true); w[bj * 2 + n] = (unsigned)p; }
                *(u32x4*)rowp = w; }
    }
};
struct EpiProj {
    static constexpr bool PERM = true;
    bf16_t *QK, *V, *R, *U, *GA, *GB;
    __device__ __forceinline__ void operator()(const f32x4 (&acc)[2][2][4][2], const Unit& u, int wr, int wc, int fr, int fq) const {
        const int pn = u.pn; bf16_t* base; int ldc = 1024, ct;
        if (pn < 4) { base = QK; ct = pn; } else if (pn < 8) { base = V; ct = pn - 4; } else if (pn < 12) { base = R; ct = pn - 8; }
        else if (pn < 14) { base = U; ct = pn - 12; ldc = 512; } else if (pn < 18) { base = GA; ct = pn - 14; } else { base = GB; ct = pn - 18; }
        const int row0 = u.pm * BM + wr * 64 + fr, col0 = ct * BM + wc * 32 + 8 * fq;
#pragma unroll
        for (int ai = 0; ai < 2; ++ai)
#pragma unroll
            for (int m = 0; m < 4; ++m) { bf16_t* rowp = base + (size_t)(row0 + ai * HALF + m * 16) * ldc + col0;
#pragma unroll
                for (int bj = 0; bj < 2; ++bj) *(u32x4*)(rowp + bj * HALF) = pack8(acc[ai][bj][m][0], acc[ai][bj][m][1]); }
    }
};
template <int MODE> struct EpiGate {
    static constexpr bool PERM = true;
    const bf16_t* G; const bf16_t* P; bf16_t* O;
    __device__ __forceinline__ void operator()(const f32x4 (&acc)[2][2][4][2], const Unit& u, int wr, int wc, int fr, int fq) const {
        const int row0 = u.pm * BM + wr * 64 + fr, col0 = u.pn * BM + wc * 32 + 8 * fq;
#pragma unroll
        for (int ai = 0; ai < 2; ++ai)
#pragma unroll
            for (int m = 0; m < 4; ++m) { const size_t off = (size_t)(row0 + ai * HALF + m * 16) * 1024 + col0;
#pragma unroll
                for (int bj = 0; bj < 2; ++bj) {
                    const u32x4 gw = NTL((const u32x4*)(G + off + bj * HALF)); f32x4 g0, g1; unpack8(gw, g0, g1);
                    f32x4 v0 = acc[ai][bj][m][0], v1 = acc[ai][bj][m][1];
#pragma unroll
                    for (int j = 0; j < 4; ++j) { v0[j] *= sigm(g0[j]); v1[j] *= sigm(g1[j]); }
                    if (MODE == 1) { const u32x4 pw = *(const u32x4*)(P + off + bj * HALF); f32x4 p0, p1; unpack8(pw, p0, p1); v0 += p0; v1 += p1; }
                    *(u32x4*)(O + off + bj * HALF) = pack8(v0, v1); } }
    }
};
struct EpiPre1 {
    static constexpr bool PERM = true;
    const float* X; bf16_t* O; float alpha; float* PST;
    __device__ __forceinline__ void operator()(const f32x4 (&acc)[2][2][4][2], const Unit& u, int wr, int wc, int fr, int fq) const {
        const int row0 = u.pm * BM + wr * 64 + fr, col0 = u.pn * BM + wc * 32 + 8 * fq;
#pragma unroll
        for (int ai = 0; ai < 2; ++ai)
#pragma unroll
            for (int m = 0; m < 4; ++m) { const int row = row0 + ai * HALF + m * 16; float s = 0.f, q = 0.f;
#pragma unroll
                for (int bj = 0; bj < 2; ++bj) { const float* xp = X + (size_t)row * 1024 + col0 + bj * HALF;
                    const f32x4 p0 = NTL((const f32x4*)xp) * alpha + acc[ai][bj][m][0], p1 = NTL((const f32x4*)(xp + 4)) * alpha + acc[ai][bj][m][1];
                    *(u32x4*)(O + (size_t)row * 2048 + col0 + bj * HALF) = pack8(p0, p1);
                    s += ((p0[0] + p0[1]) + (p0[2] + p0[3])) + ((p1[0] + p1[1]) + (p1[2] + p1[3]));
                    q += ((p0[0] * p0[0] + p0[1] * p0[1]) + (p0[2] * p0[2] + p0[3] * p0[3])) + ((p1[0] * p1[0] + p1[1] * p1[1]) + (p1[2] * p1[2] + p1[3] * p1[3])); }
                { auto a = __builtin_amdgcn_permlane16_swap(__float_as_uint(s), __float_as_uint(s), false, false); s = __uint_as_float(a[0]) + __uint_as_float(a[1]);
                  auto b = __builtin_amdgcn_permlane32_swap(__float_as_uint(s), __float_as_uint(s), false, false); s = __uint_as_float(b[0]) + __uint_as_float(b[1]);
                  auto c = __builtin_amdgcn_permlane16_swap(__float_as_uint(q), __float_as_uint(q), false, false); q = __uint_as_float(c[0]) + __uint_as_float(c[1]);
                  auto d = __builtin_amdgcn_permlane32_swap(__float_as_uint(q), __float_as_uint(q), false, false); q = __uint_as_float(d[0]) + __uint_as_float(d[1]); }
                if (fq == 0) *(f32x2*)(PST + ((size_t)row * 16 + u.pn * 4 + wc) * 2) = (f32x2){s, q}; }
    }
};
struct EpiPre2 {
    static constexpr bool PERM = true;
    bf16_t* IO; const float* ST; const float* g; const float* b; float alpha; float ascale;
    __device__ __forceinline__ void operator()(f32x4 (&acc)[2][2][4][2], const Unit& u, int wr, int wc, int fr, int fq) const {
        const unsigned row0 = (unsigned)(u.pm * BM + wr * 64 + fr), col0 = (unsigned)(u.pn * BM + wc * 32 + 8 * fq);
        const unsigned char* STb = (const unsigned char*)ST; unsigned char* IOb = (unsigned char*)IO;
#pragma unroll
        for (int bj = 0; bj < 2; ++bj) { const f32x4 g0 = *(const f32x4*)(g + col0 + bj * HALF), g1 = *(const f32x4*)(g + col0 + bj * HALF + 4), b0 = *(const f32x4*)(b + col0 + bj * HALF), b1 = *(const f32x4*)(b + col0 + bj * HALF + 4);
#pragma unroll
            for (int ai = 0; ai < 2; ++ai)
#pragma unroll
                for (int m = 0; m < 4; ++m) { const unsigned row = row0 + (unsigned)(ai * HALF + m * 16); const f32x2 st = *(const f32x2*)(STb + row * 8u);
                    u32x4* pp = (u32x4*)(IOb + (row * 2048u + col0 + (unsigned)(bj * HALF)) * 2u); f32x4 p0, p1; unpack8(NTL(pp), p0, p1);
                    const f32x4 r0 = acc[ai][bj][m][0] * ascale + ((p0 - st.x) * st.y * g0 + b0) * alpha, r1 = acc[ai][bj][m][1] * ascale + ((p1 - st.x) * st.y * g1 + b1) * alpha;
                    *pp = pack8(r0, r1); }
            asm volatile("" ::: "memory"); }
    }
};
struct EpiMoe1 {
    static constexpr bool PERM = true;
    bf16_t* H; const float* RW;
    __device__ __forceinline__ void operator()(const f32x4 (&acc)[2][2][4][2], const Unit& u, int wr, int wc, int fr, int fq) const {
        const int row0 = u.pm * BM + wr * 64 + fr, col0 = u.pn * HALF + wc * 32 + 8 * fq;
#pragma unroll
        for (int ai = 0; ai < 2; ++ai)
#pragma unroll
            for (int m = 0; m < 4; ++m) { const int row = row0 + ai * HALF + m * 16; const float w = RW[row];
                f32x4 v0, v1;
#pragma unroll
                for (int j = 0; j < 4; ++j) { const float g0 = acc[ai][0][m][0][j], g1 = acc[ai][0][m][1][j];
                    v0[j] = g0 * sigm(g0) * acc[ai][1][m][0][j] * w; v1[j] = g1 * sigm(g1) * acc[ai][1][m][1][j] * w; }
                *(u32x4*)(H + (size_t)row * 256 + col0) = pack8(v0, v1); }
    }
};

template <class Epi, class Sched, bool ALIGN_EPI, bool SP2, bool GATHER, bool FP8 = false, int F8SHIFT = 0>
__device__ __forceinline__ void gemm_phase(PG8_LAS unsigned char* lds, const bf16_t* Aop, const bf16_t* Bop, const int K_, const Sched& S, const Epi& E, const PG8_LAS int* idxtab) {
    int K = K_; asm volatile("" : "+s"(K));
    int tid_ = threadIdx.x; asm volatile("" : "+v"(tid_));
    const int tid = tid_, wid = __builtin_amdgcn_readfirstlane(tid >> 6), lane = tid & 63, wr = wid >> 2, wc = wid & 3, fr = lane & 15, fq = lane >> 4;
    const int nt = K / BK;
    unsigned voffA[2], voffB[2]; int RA[2], CA[2];
#pragma unroll
    for (int i = 0; i < 2; ++i) { int R, C; stage_rc(tid * 16 + i * 8192, R, C);
        const int Rb = (int)Epi::PERM == 2 ? (64 * (R >> 5) + 16 * ((R >> 2) & 3) + 4 * ((R >> 4) & 1) + (R & 3)) : (int)Epi::PERM == 1 ? ((R & ~31) + perm32(R & 31)) : R;
        voffA[i] = (unsigned)(R * K + C) * 2u; voffB[i] = (unsigned)(Rb * K + C) * 2u; RA[i] = R; CA[i] = C; }
    const size_t kstep = (size_t)(BK * 2);
    const size_t hstep = (size_t)HALF * K * 2;
    const size_t tstep = 2 * hstep;
    const size_t bh1 = (int)Epi::PERM == 2 ? (size_t)16 * K : hstep;
    const unsigned ldsw = (unsigned)wid * 1024u;
    const int aoff = lds_byte(wr * 64 + fr, fq * 8), boff = lds_byte(wc * 32 + fr, fq * 8);
    unsigned vAc[2][2], vAn[2][2];
#define PG8_GIDX(dst, ord) do { _Pragma("unroll") for (int _h = 0; _h < 2; ++_h) _Pragma("unroll") for (int _i = 0; _i < 2; ++_i) \
        dst[_h][_i] = (unsigned)(idxtab[(ord) * 256 + _h * HALF + RA[_i]] * K + CA[_i]) * 2u; } while (0)
#define PG8_SA(b, h) (((b) * 2 + (h)) * HTB)
#define PG8_SB(b, h) ((4 + (b) * 2 + (h)) * HTB)
#define PG8_STAGE(bufoff, gbase, voff) do { _Pragma("unroll") for (int _i = 0; _i < 2; ++_i) \
        __builtin_amdgcn_global_load_lds((const unsigned*)((const char*)(gbase) + (voff)[_i]), (PG8_LAS unsigned*)(lds + (bufoff) + ldsw + _i * 8192), 16, 0, 0); } while (0)
#define PG8_STAGE_A(bufoff, kptr, h, nx) do { if constexpr (GATHER) { unsigned _v[2]; _v[0] = (nx) ? vAn[h][0] : vAc[h][0]; _v[1] = (nx) ? vAn[h][1] : vAc[h][1]; PG8_STAGE(bufoff, kptr, _v); } \
        else { PG8_STAGE(bufoff, (kptr) + (h) * hstep, voffA); } } while (0)
#define PG8_LD8(dst, off) do { const i32x4 lo_ = *(const PG8_LAS i32x4*)(lds + (off)), hi_ = *(const PG8_LAS i32x4*)(lds + (off) + 1024); dst = __builtin_shufflevector(lo_, hi_, 0, 1, 2, 3, 4, 5, 6, 7); } while (0)
#define PG8_LDA(dst, b, h) do { if constexpr (FP8) { _Pragma("unroll") for (int m = 0; m < 4; ++m) PG8_LD8(dst##8[m], PG8_SA(b, h) + aoff + m * 2048); } \
        else { _Pragma("unroll") for (int m = 0; m < 4; ++m) _Pragma("unroll") for (int k = 0; k < 2; ++k) dst[m][k] = *(const PG8_LAS bf16x8*)(lds + PG8_SA(b, h) + aoff + m * 2048 + k * 1024); } } while (0)
#define PG8_LDB(dst, b, h) do { if constexpr (FP8) { _Pragma("unroll") for (int n = 0; n < 2; ++n) PG8_LD8(dst##8[n], PG8_SB(b, h) + boff + n * 2048); } \
        else { _Pragma("unroll") for (int n = 0; n < 2; ++n) _Pragma("unroll") for (int k = 0; k < 2; ++k) dst[n][k] = *(const PG8_LAS bf16x8*)(lds + PG8_SB(b, h) + boff + n * 2048 + k * 1024); } } while (0)
#define PG8_MMA(ai, bj, At, Bt) do { __builtin_amdgcn_s_setprio(1); \
        if constexpr (FP8) { if (zc) { _Pragma("unroll") for (int m = 0; m < 4; ++m) _Pragma("unroll") for (int n = 0; n < 2; ++n) \
                asm volatile("v_mfma_scale_f32_16x16x128_f8f6f4 %0, %1, %2, 0, %3, %4 op_sel_hi:[0,0,0]" : "=&v"(acc[ai][bj][m][n]) : "v"(Bt##8[n]), "v"(At##8[m]), "v"(f8sa), "v"(f8sb)); } \
            else { _Pragma("unroll") for (int m = 0; m < 4; ++m) _Pragma("unroll") for (int n = 0; n < 2; ++n) \
                asm volatile("v_mfma_scale_f32_16x16x128_f8f6f4 %0, %1, %2, %0, %3, %4 op_sel_hi:[0,0,0]" : "+v"(acc[ai][bj][m][n]) : "v"(Bt##8[n]), "v"(At##8[m]), "v"(f8sa), "v"(f8sb)); } } \
        else { _Pragma("unroll") for (int m = 0; m < 4; ++m) _Pragma("unroll") for (int n = 0; n < 2; ++n) _Pragma("unroll") for (int k = 0; k < 2; ++k) \
            acc[ai][bj][m][n] = __builtin_amdgcn_mfma_f32_16x16x32_bf16(Bt[n][k], At[m][k], acc[ai][bj][m][n], 0, 0, 0); } \
        __builtin_amdgcn_s_setprio(0); } while (0)
#define PG8_WAIT_V(n) asm volatile("s_waitcnt vmcnt(" #n ")" ::: "memory")
#define PG8_WAIT_L(n) asm volatile("s_waitcnt lgkmcnt(" #n ")" ::: "memory")
#define PG8_BAR __builtin_amdgcn_s_barrier()
#define PG8_SCHED __builtin_amdgcn_sched_barrier(0)
    Unit cur, nxt; int ui = 0;
    if (!S.next(0, cur)) return;
    f32x4 acc[2][2][4][2];
    if constexpr (!FP8)
#pragma unroll
    for (int a = 0; a < 2; ++a)
#pragma unroll
        for (int b = 0; b < 2; ++b)
#pragma unroll
            for (int m = 0; m < 4; ++m)
#pragma unroll
                for (int n = 0; n < 2; ++n) acc[a][b][m][n] = (f32x4){0.f, 0.f, 0.f, 0.f};
    bf16x8 At[4][2], B0[2][2], B1[2][2]; i32x8 At8[4], B08[2], B18[2];
    (void)At; (void)B0; (void)B1; (void)At8; (void)B08; (void)B18;
    int f8sa = 0x01010101 * (127 + F8SHIFT), f8sb = 0x7f7f7f7f; asm volatile("" : "+v"(f8sa), "+v"(f8sb)); (void)f8sa; (void)f8sb;
    const char* cA = (const char*)Aop + (GATHER ? (size_t)0 : (size_t)cur.at * tstep); const char* cB = (const char*)Bop + (size_t)cur.bt * tstep;
    if constexpr (GATHER) { PG8_GIDX(vAc, 0); }
    if constexpr (SP2) {
        PG8_STAGE(PG8_SB(0, 0), cB, voffB); PG8_STAGE(PG8_SB(0, 1), cB + bh1, voffB); PG8_STAGE_A(PG8_SA(0, 0), cA, 0, false); PG8_STAGE_A(PG8_SA(0, 1), cA, 1, false);
        if (wr == 1) PG8_BAR;
        PG8_WAIT_V(2); PG8_BAR;
        PG8_STAGE(PG8_SB(1, 0), cB + kstep, voffB); PG8_STAGE_A(PG8_SA(1, 0), cA + kstep, 0, false); PG8_STAGE(PG8_SB(1, 1), cB + bh1 + kstep, voffB);
        PG8_WAIT_V(6); PG8_BAR;
    } else {
        PG8_STAGE(PG8_SB(0, 0), cB, voffB); PG8_STAGE_A(PG8_SA(0, 0), cA, 0, false); PG8_STAGE(PG8_SB(0, 1), cB + bh1, voffB); PG8_STAGE_A(PG8_SA(0, 1), cA, 1, false);
        if (wr == 1) PG8_BAR;
        PG8_WAIT_V(4); PG8_BAR;
        PG8_STAGE(PG8_SB(1, 0), cB + kstep, voffB); PG8_STAGE_A(PG8_SA(1, 0), cA + kstep, 0, false); PG8_STAGE(PG8_SB(1, 1), cB + bh1 + kstep, voffB);
        PG8_WAIT_V(6); PG8_BAR;
    }
    for (;;) {
        const bool has_next = S.next(ui + 1, nxt);
        const char* nA = (has_next && !GATHER) ? (const char*)Aop + (size_t)nxt.at * tstep : cA; const char* nB = has_next ? (const char*)Bop + (size_t)nxt.bt * tstep : cB;
        if constexpr (GATHER) { if (has_next) { PG8_GIDX(vAn, ui + 1); } else {
#pragma unroll
            for (int _h = 0; _h < 2; ++_h) { vAn[_h][0] = vAc[_h][0]; vAn[_h][1] = vAc[_h][1]; } } }
#pragma nounroll
        for (int t = 0; t < nt; t += 2) {
            const bool last = (t == nt - 2);
            const char* a1 = cA + (size_t)(t + 1) * kstep;
            const char* a2 = last ? nA : cA + (size_t)(t + 2) * kstep; const char* b2 = last ? nB : cB + (size_t)(t + 2) * kstep;
            const char* a3 = a2 + kstep; const char* b3 = b2 + kstep;
            if constexpr (SP2) {
            bool zc = FP8 && (t == 0); (void)zc;
            PG8_LDB(B0, 0, 0); PG8_LDB(B1, 0, 1); PG8_SCHED; PG8_LDA(At, 0, 0); PG8_STAGE_A(PG8_SA(1, 1), a1, 1, false);
            PG8_WAIT_V(8); PG8_WAIT_L(0); PG8_BAR; PG8_MMA(0, 0, At, B0); PG8_MMA(0, 1, At, B1); PG8_BAR; PG8_SCHED;
            PG8_LDA(At, 0, 1); PG8_STAGE(PG8_SB(0, 0), b2, voffB); PG8_STAGE(PG8_SB(0, 1), b2 + bh1, voffB); PG8_STAGE_A(PG8_SA(0, 0), a2, 0, last);
            PG8_WAIT_V(8); PG8_WAIT_L(0); PG8_BAR; PG8_MMA(1, 0, At, B0); PG8_MMA(1, 1, At, B1); PG8_BAR; PG8_SCHED;
            zc = false;
            PG8_LDB(B0, 1, 0); PG8_LDB(B1, 1, 1); PG8_SCHED; PG8_LDA(At, 1, 0); PG8_STAGE_A(PG8_SA(0, 1), a2, 1, last);
            PG8_WAIT_V(8); PG8_WAIT_L(0); PG8_BAR; PG8_MMA(0, 0, At, B0); PG8_MMA(0, 1, At, B1); PG8_BAR; PG8_SCHED;
            PG8_LDA(At, 1, 1); PG8_STAGE(PG8_SB(1, 0), b3, voffB); PG8_STAGE(PG8_SB(1, 1), b3 + bh1, voffB); PG8_STAGE_A(PG8_SA(1, 0), a3, 0, last);
            PG8_WAIT_V(8); PG8_WAIT_L(0); PG8_BAR; PG8_MMA(1, 0, At, B0); PG8_MMA(1, 1, At, B1); PG8_BAR; PG8_SCHED;
            } else {
            bool zc = FP8 && (t == 0); (void)zc;
            PG8_LDB(B0, 0, 0); PG8_SCHED; PG8_LDA(At, 0, 0); PG8_STAGE_A(PG8_SA(1, 1), a1, 1, false);
            PG8_WAIT_L(8); PG8_BAR; PG8_WAIT_L(0); PG8_MMA(0, 0, At, B0); PG8_BAR; PG8_SCHED;
            PG8_LDB(B1, 0, 1); PG8_STAGE(PG8_SB(0, 0), b2, voffB);
            PG8_BAR; PG8_WAIT_L(0); PG8_MMA(0, 1, At, B1); PG8_BAR;
            PG8_LDA(At, 0, 1); PG8_STAGE_A(PG8_SA(0, 0), a2, 0, last);
            PG8_BAR; PG8_WAIT_L(0); PG8_MMA(1, 0, At, B0); PG8_BAR; PG8_SCHED;
            PG8_STAGE(PG8_SB(0, 1), b2 + bh1, voffB);
            PG8_WAIT_V(6); PG8_BAR; PG8_MMA(1, 1, At, B1); PG8_BAR;
            zc = false;
            PG8_LDB(B0, 1, 0); PG8_SCHED; PG8_LDA(At, 1, 0); PG8_STAGE_A(PG8_SA(0, 1), a2, 1, last);
            PG8_WAIT_L(8); PG8_BAR; PG8_WAIT_L(0); PG8_MMA(0, 0, At, B0); PG8_BAR; PG8_SCHED;
            PG8_LDB(B1, 1, 1); PG8_STAGE(PG8_SB(1, 0), b3, voffB);
            PG8_BAR; PG8_WAIT_L(0); PG8_MMA(0, 1, At, B1); PG8_BAR;
            PG8_LDA(At, 1, 1); PG8_STAGE_A(PG8_SA(1, 0), a3, 0, last);
            PG8_BAR; PG8_WAIT_L(0); PG8_MMA(1, 0, At, B0); PG8_BAR; PG8_SCHED;
            PG8_STAGE(PG8_SB(1, 1), b3 + bh1, voffB);
            PG8_WAIT_V(6); PG8_BAR; PG8_MMA(1, 1, At, B1); PG8_BAR;
            }
        }
        if constexpr (FP8) asm volatile("s_nop 15\n\ts_nop 15" ::: "memory");
        if constexpr (ALIGN_EPI) { if (wr == 0) PG8_BAR; }
        E(acc, cur, wr, wc, fr, fq);
        if (!has_next) break;
        if constexpr (!FP8)
#pragma unroll
        for (int a = 0; a < 2; ++a)
#pragma unroll
            for (int b = 0; b < 2; ++b)
#pragma unroll
                for (int m = 0; m < 4; ++m)
#pragma unroll
                    for (int n = 0; n < 2; ++n) acc[a][b][m][n] = (f32x4){0.f, 0.f, 0.f, 0.f};
        cur = nxt; cA = nA; cB = nB; ++ui;
        if constexpr (GATHER) {
#pragma unroll
            for (int _h = 0; _h < 2; ++_h) { vAc[_h][0] = vAn[_h][0]; vAc[_h][1] = vAn[_h][1]; } }
        if constexpr (ALIGN_EPI) { if (wr == 1) PG8_BAR; }
    }
    PG8_WAIT_V(0);
    if constexpr (!ALIGN_EPI) { if (wr == 0) PG8_BAR; }
    PG8_BAR;
#undef PG8_GIDX
#undef PG8_SA
#undef PG8_SB
#undef PG8_STAGE
#undef PG8_STAGE_A
#undef PG8_LDA
#undef PG8_LDB
#undef PG8_MMA
#undef PG8_LD8
#undef PG8_WAIT_V
#undef PG8_WAIT_L
#undef PG8_BAR
#undef PG8_SCHED
}
}
#ifndef PG8_SP2
#define PG8_SP2 true
#endif
#ifndef PG8_ALIGN
#define PG8_ALIGN true
#endif
#ifndef MK_FUSED
#define MK_FUSED 1
#endif

constexpr int NWAVES = 8;
constexpr int BATCH = 2, SEQ = 16384, D = 1024, T = BATCH * SEQ;
constexpr int IN_COLS = 5648, NPROJ = 5632;
constexpr int GH = 4, GDK = 128, GDV = 256, GRANK = 16;
constexpr int PW = 512;
constexpr int NE = 64, TOPK = 8, NGRP = 8, FF = 256;
constexpr float LN_EPS = 1e-5f, RMS_EPS = 1e-6f;
constexpr float DN_ALPHA = 1.189207115002721f;
constexpr float ROUTE_SCALE = 2.5f;
constexpr int ROUTED_TILES = 1088, SH_TILES = T / 256;
constexpr float Y_SCALE = 16.0f;
constexpr float W_SCALE = 32.0f, H_SCALE = 16.0f;
constexpr int ALL_ROWS = (ROUTED_TILES + SH_TILES) * 256;

constexpr size_t MiB = 1u << 20;
constexpr size_t WS_CTL = 0, CTL_ZERO_BYTES = 1 * MiB;
constexpr size_t WS_TAB = 1 * MiB;
constexpr size_t TAB_CNT = WS_TAB, TAB_TILEE = WS_TAB + 65536, TAB_META = WS_TAB + 73728, TAB_STATS = WS_TAB + 262144;
constexpr size_t WS_WIN = 2 * MiB, WS_WGLA = 13 * MiB, WS_WPC = 15 * MiB, WS_WOUT = 16 * MiB;
constexpr size_t WS_GLR = 18 * MiB;
constexpr size_t WS_L = 20 * MiB;
constexpr size_t WS_XB = 52 * MiB;
constexpr size_t WS_PO = 52 * MiB, WS_OG = 84 * MiB;
constexpr size_t WS_QK = 148 * MiB, WS_V = 212 * MiB, WS_R = 276 * MiB, WS_U = 340 * MiB, WS_GA = 372 * MiB, WS_GB = 436 * MiB;
constexpr size_t WS_T1 = WS_QK, WS_MG = WS_V;
constexpr size_t WS_TOKE = 2 * MiB, WS_TOKW = 3 * MiB, WS_TOKLR = 4 * MiB, WS_TOKSLOT = 5 * MiB, WS_ROWTOK = 6 * MiB, WS_ROWW = 8 * MiB;
constexpr size_t WS_H1F = 10 * MiB;
constexpr size_t WS_W1 = 42 * MiB;
constexpr size_t WS_Y = 10 * MiB;
constexpr size_t WS_H = 319 * MiB;
constexpr size_t WS_W2 = 479 * MiB;
constexpr size_t WS_PST = 500 * MiB;
constexpr size_t WS_END = 512 * MiB;
static_assert(WS_WIN + (size_t)NPROJ * D * 2 <= WS_WGLA && WS_GB + (size_t)T * D * 2 <= 500 * MiB, "map 1");
static_assert(WS_ROWTOK + (size_t)ALL_ROWS * 4 <= WS_ROWW && WS_ROWW + (size_t)ALL_ROWS * 4 <= WS_H1F && WS_H1F + (size_t)T * D <= WS_W1, "map 2");
static_assert(WS_W1 + (size_t)65 * 512 * 1024 <= WS_H && WS_Y + (size_t)ROUTED_TILES * 256 * 1024 <= WS_H && WS_H + (size_t)ALL_ROWS * 256 <= WS_W2 && WS_W2 + (size_t)65 * 1024 * 256 <= WS_PST, "map 3");
constexpr int CW_TMO = 0, CW_CODE = 1;
constexpr int CW_BAR = 4096;
constexpr int MT_NT = 0, MT_ESTART = 16, MT_ECNT = 96;

constexpr int RING_OFF = 0, RING_BYTES = 131072;
constexpr int IDX_OFF = RING_BYTES, IDX_UNITS = 12, IDX_BYTES = IDX_UNITS * 1024;
constexpr int LDSCTL_OFF = IDX_OFF + IDX_BYTES, MISC_OFF = LDSCTL_OFF + 320;
constexpr int LDS_BYTES = 147456;
static_assert(MISC_OFF + 128 <= LDS_BYTES, "LDS map");

#define GAS __attribute__((address_space(1)))
#define LAS __attribute__((address_space(3)))
typedef unsigned short bf16;
typedef unsigned v4u __attribute__((ext_vector_type(4)));
typedef unsigned v2u __attribute__((ext_vector_type(2)));
typedef float f32x4 __attribute__((ext_vector_type(4)));
typedef float f32x2 __attribute__((ext_vector_type(2)));
typedef GAS unsigned gu32;
#define RLX_AGENT __ATOMIC_RELAXED, __HIP_MEMORY_SCOPE_AGENT
#define LDS_WAIT() asm volatile("s_waitcnt lgkmcnt(0)" ::: "memory")
#define VM_WAIT() asm volatile("s_waitcnt vmcnt(0)" ::: "memory")
__device__ __forceinline__ unsigned f2bf(float f) { unsigned u = __builtin_bit_cast(unsigned, f); return (u + 0x7fffu + ((u >> 16) & 1u)) >> 16; }
__device__ __forceinline__ unsigned pk2(float lo, float hi) { return f2bf(lo) | (f2bf(hi) << 16); }
__device__ __forceinline__ float bf2f(bf16 b) { return __uint_as_float((unsigned)b << 16); }
__device__ __forceinline__ float blo(unsigned w) { return __uint_as_float(w << 16); }
__device__ __forceinline__ float bhi(unsigned w) { return __uint_as_float(w & 0xffff0000u); }
__device__ __forceinline__ float sigmoidf_(float x) { return 1.0f / (1.0f + __expf(-x)); }

#define XB_TMO      128
#define XB_XCNT(j)  (256  + 64 * (j))
#define XB_XSUB(j)  (1280 + 64 * (j))
#define XB_XGEN(j)  (2304 + 64 * (j))
#define XB_TOP      3328
#define XB_TOPGEN   3392
#define XCD_BAR_WORDS 3456
#define XB_SPIN_CAP (1u << 18)

__device__ __forceinline__ unsigned xb_ld(unsigned* p)              { return __hip_atomic_load(p, __ATOMIC_RELAXED, __HIP_MEMORY_SCOPE_AGENT); }
__device__ __forceinline__ unsigned xb_add(unsigned* p, unsigned v) { return __hip_atomic_fetch_add(p, v, __ATOMIC_RELAXED, __HIP_MEMORY_SCOPE_AGENT); }
__device__ __forceinline__ unsigned xb_xcc_id() { return (unsigned)__builtin_amdgcn_s_getreg((3 << 11) | 20) & 0xFu; }
#define XB_SPIN(cond, bar) do { unsigned _sp = 0; while (cond) { __builtin_amdgcn_s_sleep(1); \
    if ((++_sp & 255u) == 0u) { if (xb_ld(&(bar)[XB_TMO])) break; if (_sp > XB_SPIN_CAP) { atomicAdd(&(bar)[XB_TMO], 1u); break; } } } } while (0)

struct XcdBarrier { unsigned* bar; unsigned x; volatile LAS unsigned* st; };

__device__ __forceinline__ XcdBarrier xcd_barrier_post(unsigned* bar, volatile LAS unsigned* st) {
    XcdBarrier b; b.bar = bar; b.x = xb_xcc_id(); b.st = st;
    if (threadIdx.x == 0) (void)xb_add(&bar[XB_XCNT(b.x)], 1u);
    return b;
}
__device__ __forceinline__ void xcd_barrier_complete(unsigned* bar, unsigned x, unsigned& nloc, unsigned& nx) {
    const unsigned G = gridDim.x * gridDim.y * gridDim.z;
    unsigned sum, cnt, mine, sp = 0u;
    for (;;) {
        sum = 0u; cnt = 0u; mine = 0u;
#pragma unroll
        for (unsigned j = 0; j < 16; ++j) { const unsigned c = xb_ld(&bar[XB_XCNT(j)]); sum += c; cnt += (c > 0u) ? 1u : 0u; mine = (j == x) ? c : mine; }
        if (sum == G) break;
        __builtin_amdgcn_s_sleep(1);
        if ((++sp & 255u) == 0u) { if (xb_ld(&bar[XB_TMO])) break; if (sp > XB_SPIN_CAP) { atomicAdd(&bar[XB_TMO], 1u); break; } }
    }
    nloc = mine > 0u ? mine : 1u; nx = cnt > 0u ? cnt : 1u;
}
__device__ __forceinline__ void xcd_barrier(const XcdBarrier& b) {
    asm volatile("s_waitcnt vmcnt(0)" ::: "memory");
    __syncthreads();
    if (threadIdx.x == 0) {
        unsigned* bar = b.bar;
        __builtin_amdgcn_s_waitcnt(0);
        unsigned nloc = b.st[0], nx = b.st[1];
        if (nloc == 0u) { xcd_barrier_complete(bar, b.x, nloc, nx); b.st[0] = nloc; b.st[1] = nx; }
        const unsigned old = xb_add(&bar[XB_XSUB(b.x)], 1u);
        const unsigned gen = old / nloc;
        if (old + 1u == (gen + 1u) * nloc) {
            __builtin_amdgcn_fence(__ATOMIC_RELEASE, "agent");
            asm volatile("s_waitcnt vmcnt(0)" ::: "memory");
            const unsigned og = xb_add(&bar[XB_TOP], 1u);
            const unsigned tg = og / nx;
            if (og + 1u == (tg + 1u) * nx) xb_add(&bar[XB_TOPGEN], 1u);
            else XB_SPIN(xb_ld(&bar[XB_TOPGEN]) == tg, bar);
            __builtin_amdgcn_fence(__ATOMIC_ACQUIRE, "agent");
            xb_add(&bar[XB_XGEN(b.x)], 1u);
            asm volatile("s_waitcnt vmcnt(0)" ::: "memory");
        } else {
            XB_SPIN(xb_ld(&bar[XB_XGEN(b.x)]) == gen, bar);
            __builtin_amdgcn_fence(__ATOMIC_ACQUIRE, "agent");
            asm volatile("s_waitcnt vmcnt(0)" ::: "memory");
        }
    }
    __syncthreads();
}

struct Frame {
    LAS unsigned char* lds;
    volatile LAS unsigned* MISC;
    gu32* ctl;
    unsigned char* ws;
    int tid, lane, wave;
    int vcu, G;
    const float *x, *w_in, *w_gate_up, *b_gate, *gla_norm_g, *w_gla_up, *w_pool_grp, *pool_scale, *w_pool_up, *w_out, *ln1_g, *ln1_b, *w_router, *router_bias,
                *w_exp_gate, *w_exp_up, *w_exp_down, *w_sh_gate, *w_sh_up, *w_sh_down, *ln2_g, *ln2_b;
    float* out;
};
template <int CTRL> __device__ __forceinline__ float dppf(float x) { return __builtin_bit_cast(float, __builtin_amdgcn_mov_dpp(__builtin_bit_cast(int, x), CTRL, 0xf, 0xf, true)); }
template <int CTRL> __device__ __forceinline__ int dppi(int x) { return __builtin_amdgcn_mov_dpp(x, CTRL, 0xf, 0xf, true); }
constexpr int DPP_XOR1 = 0xB1, DPP_XOR2 = 0x4E, DPP_ROR4 = 0x124, DPP_ROR8 = 0x128, DPP_Q0 = 0x00, DPP_Q1 = 0x55, DPP_Q2 = 0xAA, DPP_Q3 = 0xFF;
__device__ __forceinline__ float xrow16_sumf(float x) {
    auto s = __builtin_amdgcn_permlane16_swap(__float_as_uint(x), __float_as_uint(x), false, false);
    x = __uint_as_float(s[0]) + __uint_as_float(s[1]);
    auto t = __builtin_amdgcn_permlane32_swap(__float_as_uint(x), __float_as_uint(x), false, false);
    return __uint_as_float(t[0]) + __uint_as_float(t[1]);
}
__device__ __forceinline__ float wave_sum(float v) {
    v += dppf<DPP_XOR1>(v); v += dppf<DPP_XOR2>(v); v += dppf<DPP_ROR4>(v); v += dppf<DPP_ROR8>(v);
    return xrow16_sumf(v);
}
#define LDS_BARRIER() do { asm volatile("s_waitcnt lgkmcnt(0)" ::: "memory"); __builtin_amdgcn_s_barrier(); asm volatile("" ::: "memory"); } while (0)
typedef __bf16 bf16x2_t __attribute__((ext_vector_type(2)));
__device__ __forceinline__ unsigned cvtpk(float lo, float hi) { f32x2 v = {lo, hi}; bf16x2_t b = __builtin_convertvector(v, bf16x2_t); return __builtin_bit_cast(unsigned, b); }
__device__ __forceinline__ void tr_item(const float* W, int ldw, int k0, int n0s, bf16* WT, int ldd, int n0d, float scale, LAS float* scr, int lane) {
    float tv[32];
#pragma unroll
    for (int i = 0; i < 32; ++i) { const int kk = 2 * i + (lane >> 5); tv[i] = NTL(W + (size_t)(k0 + kk) * ldw + n0s + (lane & 31)); }
#pragma unroll
    for (int i = 0; i < 32; ++i) { const int kk = 2 * i + (lane >> 5); scr[kk * 33 + (lane & 31)] = tv[i] * scale; }
    LDS_WAIT(); asm volatile("" ::: "memory");
    const int c = lane & 7;
#pragma unroll
    for (int j = 0; j < 4; ++j) { const int n = (lane >> 3) + 8 * j; const LAS float* s = scr + (8 * c) * 33 + n;
        v4u o; o.x = pk2(s[0 * 33], s[1 * 33]); o.y = pk2(s[2 * 33], s[3 * 33]); o.z = pk2(s[4 * 33], s[5 * 33]); o.w = pk2(s[6 * 33], s[7 * 33]);
        *(GAS v4u*)(WT + (size_t)(n0d + n) * ldd + k0 + 8 * c) = o; }
    LDS_WAIT(); asm volatile("" ::: "memory");
}

__device__ __forceinline__ void tr_item8(const float* W, int ldw, int k0, int n0s, unsigned char* WT, int ldd, int n0d, float scale, LAS float* scr, int lane) {
    float tv[32];
#pragma unroll
    for (int i = 0; i < 32; ++i) { const int kk = 2 * i + (lane >> 5); tv[i] = NTL(W + (size_t)(k0 + kk) * ldw + n0s + (lane & 31)); }
#pragma unroll
    for (int i = 0; i < 32; ++i) { const int kk = 2 * i + (lane >> 5); scr[kk * 33 + (lane & 31)] = tv[i] * scale; }
    LDS_WAIT(); asm volatile("" ::: "memory");
#pragma unroll
    for (int j = 0; j < 2; ++j) { const int c = lane + 64 * j, n = c >> 2, kc = c & 3; const LAS float* sp = scr + (16 * kc) * 33 + n;
        v4u o; o.x = pg8::pk4_fp8(sp[0 * 33], sp[1 * 33], sp[2 * 33], sp[3 * 33]); o.y = pg8::pk4_fp8(sp[4 * 33], sp[5 * 33], sp[6 * 33], sp[7 * 33]);
        o.z = pg8::pk4_fp8(sp[8 * 33], sp[9 * 33], sp[10 * 33], sp[11 * 33]); o.w = pg8::pk4_fp8(sp[12 * 33], sp[13 * 33], sp[14 * 33], sp[15 * 33]);
        *(GAS v4u*)(WT + (size_t)(n0d + n) * ldd + k0 + 16 * kc) = o; }
    LDS_WAIT(); asm volatile("" ::: "memory");
}
__device__ __forceinline__ void router_prep(Frame& F);
__device__ __forceinline__ void p0_prologue(Frame& F) {
    LAS float* scr = (LAS float*)(F.lds + RING_OFF + F.wave * 16384);
    const int gw = F.vcu * NWAVES + F.wave, NGW = F.G * NWAVES;
    bf16* Win = (bf16*)(F.ws + WS_WIN); bf16* Wgla = (bf16*)(F.ws + WS_WGLA); bf16* Wpc = (bf16*)(F.ws + WS_WPC); bf16* Wout = (bf16*)(F.ws + WS_WOUT);
    constexpr int I_IN = 16 * (NPROJ / 32), I_SQ = 16 * 32;
    for (int it = gw; it < I_IN + 2 * I_SQ; it += NGW) {
        int r = it;
        if (r < I_IN) { const int kb = r / (NPROJ / 32), nb = r % (NPROJ / 32), n0d = 32 * nb, n0s = n0d < 3072 ? n0d : n0d + 16;
            tr_item(F.w_in, IN_COLS, 64 * kb, n0s, Win, D, n0d, n0d < 512 ? 0.08838834764831845f : 1.0f, scr, F.lane); continue; }
        r -= I_IN;
        if (r < I_SQ) { tr_item(F.w_gla_up, D, 64 * (r / 32), 32 * (r % 32), Wgla, D, 32 * (r % 32), 1.0f, scr, F.lane); continue; }
        r -= I_SQ;
        tr_item(F.w_out, D, 64 * (r / 32), 32 * (r % 32), Wout, D, 32 * (r % 32), 1.0f, scr, F.lane);
    }
    __syncthreads();
    for (int it = F.vcu; it < 4 * 32; it += F.G) {
        const int g = it >> 5, n0 = (it & 31) * 32;
        LAS float* As = (LAS float*)(F.lds + RING_OFF); LAS float* Bs = As + 128 * 129;
        for (int i = F.tid; i < 128 * 128; i += NWAVES * 64) { const int c = i >> 7, e = i & 127; As[c * 129 + e] = F.w_pool_grp[(size_t)(g * 128 + c) * 128 + e] * F.pool_scale[g * 128 + e]; }
        for (int i = F.tid; i < 128 * 32; i += NWAVES * 64) { const int e = i >> 5, n = i & 31; Bs[e * 33 + n] = F.w_pool_up[(size_t)(g * 128 + e) * D + n0 + n]; }
        __syncthreads();
        { const int n = F.tid & 31, cg = F.tid >> 5; float a[8];
#pragma unroll
          for (int i = 0; i < 8; ++i) a[i] = 0.f;
#pragma unroll 4
          for (int e = 0; e < 128; ++e) { const float bv = Bs[e * 33 + n];
#pragma unroll
              for (int i = 0; i < 8; ++i) a[i] += As[(8 * cg + i) * 129 + e] * bv; }
          v4u o; o.x = pk2(a[0], a[1]); o.y = pk2(a[2], a[3]); o.z = pk2(a[4], a[5]); o.w = pk2(a[6], a[7]);
          *(GAS v4u*)(Wpc + (size_t)(n0 + n) * PW + g * 128 + 8 * cg) = o; }
        __syncthreads();
    }
    router_prep(F);
    __syncthreads();
    { LAS v4u* wf = (LAS v4u*)(F.lds + RING_OFF);
      for (int id = F.tid; id < 32 * 2 * 64; id += NWAVES * 64) { const int ln = id & 63, pp = (id >> 6) & 1, ks = id >> 7, r = ln & 15, dbase = 32 * ks + 8 * (ln >> 4);
          float v[8];
#pragma unroll
          for (int j = 0; j < 8; ++j) { const float w = F.w_in[(size_t)(dbase + j) * IN_COLS + 3072 + r]; const float hi = __uint_as_float(f2bf(w) << 16); v[j] = pp ? (w - hi) : w; }
          v4u o; o.x = pk2(v[0], v[1]); o.y = pk2(v[2], v[3]); o.z = pk2(v[4], v[5]); o.w = pk2(v[6], v[7]); wf[id] = o; }
      __syncthreads();
      bf16* XB = (bf16*)(F.ws + WS_XB); float* GLR = (float*)(F.ws + WS_GLR);
      const int row = F.lane & 15, kg = F.lane >> 4;
      for (int tile = gw; tile < T / 16; tile += NGW) {
          const int t0 = tile * 16;
          const GAS f32x4* xp = (const GAS f32x4*)(F.x + (size_t)(t0 + row) * D + 8 * kg);
          GAS v4u* ob = (GAS v4u*)(XB + (size_t)(t0 + row) * D + 8 * kg);
          pg8::f32x4 acc = (pg8::f32x4){0.f, 0.f, 0.f, 0.f};
#pragma unroll 8
          for (int ks = 0; ks < 32; ++ks) {
              const f32x4 x0 = NTL(xp + 8 * ks), x1 = NTL(xp + 8 * ks + 1);
              v4u ah; ah.x = cvtpk(x0.x, x0.y); ah.y = cvtpk(x0.z, x0.w); ah.z = cvtpk(x1.x, x1.y); ah.w = cvtpk(x1.z, x1.w);
              v4u al; al.x = cvtpk(x0.x - blo(ah.x), x0.y - bhi(ah.x)); al.y = cvtpk(x0.z - blo(ah.y), x0.w - bhi(ah.y)); al.z = cvtpk(x1.x - blo(ah.z), x1.y - bhi(ah.z)); al.w = cvtpk(x1.z - blo(ah.w), x1.w - bhi(ah.w));
              ob[4 * ks] = ah;
              const pg8::bf16x8 Ah = __builtin_bit_cast(pg8::bf16x8, ah), Al = __builtin_bit_cast(pg8::bf16x8, al);
              const pg8::bf16x8 bh = __builtin_bit_cast(pg8::bf16x8, wf[(ks * 2 + 0) * 64 + F.lane]), bl = __builtin_bit_cast(pg8::bf16x8, wf[(ks * 2 + 1) * 64 + F.lane]);
              acc = __builtin_amdgcn_mfma_f32_16x16x32_bf16(Ah, bh, acc, 0, 0, 0);
              acc = __builtin_amdgcn_mfma_f32_16x16x32_bf16(Al, bh, acc, 0, 0, 0);
              acc = __builtin_amdgcn_mfma_f32_16x16x32_bf16(Ah, bl, acc, 0, 0, 0);
          }
#pragma unroll
          for (int r = 0; r < 4; ++r) GLR[(size_t)(t0 + 4 * kg + r) * GRANK + row] = acc[r];
      }
    }
}

template <int WIN> __device__ __forceinline__ void pool_item(const bf16* U, bf16* PO, int t, int c8) {
    const int pos = t & (SEQ - 1);
    v4u w[WIN];
#pragma unroll
    for (int j = 0; j < WIN; ++j) { const int tj = (j <= pos) ? t - j : t; w[j] = *(const GAS v4u*)(U + (size_t)tj * PW + c8 * 8); }
    float s[8];
#pragma unroll
    for (int q = 0; q < 8; ++q) s[q] = 0.f;
#pragma unroll
    for (int j = 0; j < WIN; ++j) { const float m = (j <= pos) ? 1.f : 0.f;
        s[0] += m * blo(w[j].x); s[1] += m * bhi(w[j].x); s[2] += m * blo(w[j].y); s[3] += m * bhi(w[j].y); s[4] += m * blo(w[j].z); s[5] += m * bhi(w[j].z); s[6] += m * blo(w[j].w); s[7] += m * bhi(w[j].w); }
    const int cnt = (pos + 1 < WIN) ? pos + 1 : WIN; const float ic = 1.0f / (float)cnt; const v4u cur = w[0];
    v4u o; o.x = pk2(s[0] * ic - blo(cur.x), s[1] * ic - bhi(cur.x)); o.y = pk2(s[2] * ic - blo(cur.y), s[3] * ic - bhi(cur.y));
    o.z = pk2(s[4] * ic - blo(cur.z), s[5] * ic - bhi(cur.z)); o.w = pk2(s[6] * ic - blo(cur.w), s[7] * ic - bhi(cur.w));
    *(GAS v4u*)(PO + (size_t)t * PW + c8 * 8) = o;
}
template <int WIN> __device__ __forceinline__ void pool_loop(Frame& F, const bf16* U, bf16* PO, int grp) {
    const int gw = F.vcu * NWAVES + F.wave, NGW = F.G * NWAVES;
#pragma unroll 2
    for (int it = gw; it < (T / 4) * 4; it += NGW) pool_item<WIN>(U, PO, (it >> 2) * 4 + (F.lane >> 4), grp * 16 + (F.lane & 15));
}
__device__ __forceinline__ void pool_phase(Frame& F) {
    const bf16* U = (const bf16*)(F.ws + WS_U); bf16* PO = (bf16*)(F.ws + WS_PO);
    const int grp = (F.vcu * NWAVES + F.wave) & 3;
    if ((F.G * NWAVES) & 3) {
        const int gw = F.vcu * NWAVES + F.wave, NGW = F.G * NWAVES;
        for (int it = gw; it < (T / 4) * 4; it += NGW) { const int tq = it >> 2, g2 = it & 3, t = tq * 4 + (F.lane >> 4), c8 = g2 * 16 + (F.lane & 15);
            if (g2 == 0) pool_item<2>(U, PO, t, c8); else if (g2 == 1) pool_item<4>(U, PO, t, c8); else if (g2 == 2) pool_item<8>(U, PO, t, c8); else pool_item<16>(U, PO, t, c8); }
        return;
    }
    if (grp == 0) pool_loop<2>(F, U, PO, 0); else if (grp == 1) pool_loop<4>(F, U, PO, 1); else if (grp == 2) pool_loop<8>(F, U, PO, 2); else pool_loop<16>(F, U, PO, 3);
}

__device__ __forceinline__ void expert_w1_phase(Frame& F) {
    LAS float* scr = (LAS float*)(F.lds + RING_OFF + F.wave * 16384);
    const int gw = F.vcu * NWAVES + F.wave, NGW = F.G * NWAVES;
    unsigned char* W1 = F.ws + WS_W1;
    for (int it = gw; it < 65 * 2 * 128; it += NGW) {
        const int e = it >> 8, mat = (it >> 7) & 1, kb = (it >> 3) & 15, nb = it & 7, f0 = 32 * nb;
        const float* src = (e < NE) ? ((mat ? F.w_exp_up : F.w_exp_gate) + (size_t)e * D * FF) : (mat ? F.w_sh_up : F.w_sh_gate);
        tr_item8(src, FF, 64 * kb, f0, W1 + (size_t)e * 512 * D, D, 256 * (f0 >> 7) + (f0 & 127) + 128 * mat, W_SCALE, scr, F.lane);
    }
}
__device__ __forceinline__ void expert_w2_phase(Frame& F) {
    LAS float* scr = (LAS float*)(F.lds + RING_OFF + F.wave * 16384);
    const int gw = F.vcu * NWAVES + F.wave, NGW = F.G * NWAVES;
    unsigned char* W2 = F.ws + WS_W2;
    for (int it = gw; it < 65 * 128; it += NGW) {
        const int e = it >> 7, kb = (it >> 5) & 3, nb = it & 31;
        const float* src = (e < NE) ? (F.w_exp_down + (size_t)e * FF * D) : F.w_sh_down;
        tr_item8(src, D, 64 * kb, 32 * nb, W2 + (size_t)e * D * FF, FF, 32 * nb, W_SCALE, scr, F.lane);
    }
}

constexpr size_t TAB_WRT = WS_TAB + 524288, TAB_CGB = WS_TAB + 786432;
__device__ __forceinline__ void router_prep(Frame& F) {
    v4u* WRT = (v4u*)(F.ws + TAB_WRT);
    const int gt = F.vcu * (NWAVES * 64) + F.tid, NT = F.G * NWAVES * 64;
    for (int id = gt; id < 32 * 4 * 2 * 64; id += NT) {
        const int ln = id & 63, p = (id >> 6) & 1, nt = (id >> 7) & 3, ks = id >> 9, e = 16 * nt + (ln & 15), dbase = 32 * ks + 8 * (ln >> 4);
        float v[8];
#pragma unroll
        for (int j = 0; j < 8; ++j) { const float w = F.w_router[(size_t)(dbase + j) * NE + e]; const float hi = __uint_as_float(f2bf(w) << 16); v[j] = p ? (w - hi) : w; }
        v4u o; o.x = pk2(v[0], v[1]); o.y = pk2(v[2], v[3]); o.z = pk2(v[4], v[5]); o.w = pk2(v[6], v[7]);
        WRT[id] = o;
    }
}
__device__ __forceinline__ void router_phase(Frame& F) {
    const bf16* PRE = (const bf16*)F.out; unsigned char* H1F = F.ws + WS_H1F; float* ST = (float*)(F.ws + TAB_STATS); const float* PST = (const float*)(F.ws + WS_PST);
    int* TOKE = (int*)(F.ws + WS_TOKE); float* TOKW = (float*)(F.ws + WS_TOKW); int* TOKLR = (int*)(F.ws + WS_TOKLR); int* CNT = (int*)(F.ws + TAB_CNT);
    const v4u* WRT = (const v4u*)(F.ws + TAB_WRT);
    LAS float* lgt = (LAS float*)(F.lds + F.wave * 4096);
    LAS int* lcnt = (LAS int*)(F.lds + LDSCTL_OFF);
    LAS float* lgb = (LAS float*)(F.lds + IDX_OFF);
    const int lane = F.lane, row = lane & 15, kg = lane >> 4, q = lane & 3;
    for (int i = F.tid; i < 2 * D; i += NWAVES * 64) lgb[i] = i < D ? F.ln1_g[i] : F.ln1_b[i - D];
    for (int tile = F.vcu; tile < T / 128; tile += F.G) {
        if (F.tid < 64) lcnt[F.tid] = 0;
        __syncthreads();
        const int t0 = tile * 128 + F.wave * 16;
        float mean, rstd;
        { const GAS f32x4* pp = (const GAS f32x4*)(PST + (size_t)(t0 + row) * 32); float s1 = 0.f, s2 = 0.f;
#pragma unroll
          for (int i = 0; i < 8; ++i) { const f32x4 v = pp[i]; s1 += v.x + v.z; s2 += v.y + v.w; }
          mean = s1 * (1.f / D); rstd = 1.f / sqrtf(fmaxf(s2 * (1.f / D) - mean * mean, 0.f) + LN_EPS); }
        if (kg == 0) *(GAS f32x2*)(ST + 2 * (size_t)(t0 + row)) = (f32x2){mean, rstd};
        pg8::f32x4 acc[4];
#pragma unroll
        for (int nt = 0; nt < 4; ++nt) acc[nt] = (pg8::f32x4){0.f, 0.f, 0.f, 0.f};
        const GAS v4u* xp = (const GAS v4u*)(PRE + (size_t)(t0 + row) * 2048 + 8 * kg);
        GAS v2u* ob = (GAS v2u*)(H1F + (size_t)(t0 + row) * D + 8 * kg);
        LAS v4u* wl = (LAS v4u*)(F.lds + RING_OFF);
#pragma unroll 1
        for (int kh = 0; kh < 2; ++kh) {
            { const GAS v4u* src = (const GAS v4u*)WRT + (size_t)kh * 8192 + F.tid; v4u tmp[16];
#pragma unroll
              for (int i = 0; i < 16; ++i) tmp[i] = src[i * 512];
#pragma unroll
              for (int i = 0; i < 16; ++i) wl[F.tid + i * 512] = tmp[i]; }
            __syncthreads();
#pragma unroll 8
            for (int kl = 0; kl < 16; ++kl) {
                const int ks = kh * 16 + kl;
                const v4u xw = NTL(xp + 4 * ks); f32x4 x0 = (f32x4){blo(xw.x), bhi(xw.x), blo(xw.y), bhi(xw.y)}, x1 = (f32x4){blo(xw.z), bhi(xw.z), blo(xw.w), bhi(xw.w)};
                const f32x4 g0 = *(const LAS f32x4*)(lgb + 32 * ks + 8 * kg), g1 = *(const LAS f32x4*)(lgb + 32 * ks + 8 * kg + 4), b0 = *(const LAS f32x4*)(lgb + D + 32 * ks + 8 * kg), b1 = *(const LAS f32x4*)(lgb + D + 32 * ks + 8 * kg + 4);
                x0 = (x0 - mean) * rstd * g0 + b0; x1 = (x1 - mean) * rstd * g1 + b1;
                v4u ah; ah.x = cvtpk(x0.x, x0.y); ah.y = cvtpk(x0.z, x0.w); ah.z = cvtpk(x1.x, x1.y); ah.w = cvtpk(x1.z, x1.w);
                v4u al; al.x = cvtpk(x0.x - blo(ah.x), x0.y - bhi(ah.x)); al.y = cvtpk(x0.z - blo(ah.y), x0.w - bhi(ah.y)); al.z = cvtpk(x1.x - blo(ah.z), x1.y - bhi(ah.z)); al.w = cvtpk(x1.z - blo(ah.w), x1.w - bhi(ah.w));
                ob[4 * ks] = (v2u){pg8::pk4_fp8(x0.x, x0.y, x0.z, x0.w), pg8::pk4_fp8(x1.x, x1.y, x1.z, x1.w)};
                const pg8::bf16x8 Ah = __builtin_bit_cast(pg8::bf16x8, ah), Al = __builtin_bit_cast(pg8::bf16x8, al);
#pragma unroll
                for (int nt = 0; nt < 4; ++nt) { const pg8::bf16x8 bh = __builtin_bit_cast(pg8::bf16x8, wl[((kl * 4 + nt) * 2 + 0) * 64 + lane]), bl = __builtin_bit_cast(pg8::bf16x8, wl[((kl * 4 + nt) * 2 + 1) * 64 + lane]);
                    acc[nt] = __builtin_amdgcn_mfma_f32_16x16x32_bf16(Ah, bh, acc[nt], 0, 0, 0);
                    acc[nt] = __builtin_amdgcn_mfma_f32_16x16x32_bf16(Al, bh, acc[nt], 0, 0, 0);
                    acc[nt] = __builtin_amdgcn_mfma_f32_16x16x32_bf16(Ah, bl, acc[nt], 0, 0, 0); }
            }
            __syncthreads();
        }
#pragma unroll
        for (int r = 0; r < 4; ++r)
#pragma unroll
            for (int nt = 0; nt < 4; ++nt) lgt[(4 * kg + r) * 64 + 16 * nt + row] = acc[nt][r];
        LDS_WAIT(); asm volatile("" ::: "memory");
        {
            const int tk = lane >> 2, t = t0 + tk;
            float sc[16], mb[16];
#pragma unroll
            for (int i4 = 0; i4 < 4; ++i4) { const f32x4 l4 = *(const LAS f32x4*)(lgt + tk * 64 + 16 * q + 4 * i4); const f32x4 b4 = *(const GAS f32x4*)(F.router_bias + 16 * q + 4 * i4);
                sc[4 * i4] = 1.0f / (1.0f + expf(-l4.x)); sc[4 * i4 + 1] = 1.0f / (1.0f + expf(-l4.y)); sc[4 * i4 + 2] = 1.0f / (1.0f + expf(-l4.z)); sc[4 * i4 + 3] = 1.0f / (1.0f + expf(-l4.w));
                mb[4 * i4] = sc[4 * i4] + b4.x; mb[4 * i4 + 1] = sc[4 * i4 + 1] + b4.y; mb[4 * i4 + 2] = sc[4 * i4 + 2] + b4.z; mb[4 * i4 + 3] = sc[4 * i4 + 3] + b4.w; }
            float gs0, gs1;
            { float m1 = -INFINITY, m2 = -INFINITY;
#pragma unroll
              for (int i = 0; i < 8; ++i) { const float v = mb[i]; m2 = fmaxf(m2, fminf(m1, v)); m1 = fmaxf(m1, v); }
              gs0 = m1 + m2; m1 = -INFINITY; m2 = -INFINITY;
#pragma unroll
              for (int i = 8; i < 16; ++i) { const float v = mb[i]; m2 = fmaxf(m2, fminf(m1, v)); m1 = fmaxf(m1, v); }
              gs1 = m1 + m2; }
            float G8[8];
            G8[0] = dppf<DPP_Q0>(gs0); G8[1] = dppf<DPP_Q0>(gs1); G8[2] = dppf<DPP_Q1>(gs0); G8[3] = dppf<DPP_Q1>(gs1); G8[4] = dppf<DPP_Q2>(gs0); G8[5] = dppf<DPP_Q2>(gs1); G8[6] = dppf<DPP_Q3>(gs0); G8[7] = dppf<DPP_Q3>(gs1);
            int rk0 = 0, rk1 = 0;
#pragma unroll
            for (int g = 0; g < 8; ++g) { rk0 += (G8[g] > gs0 || (G8[g] == gs0 && g < 2 * q)) ? 1 : 0; rk1 += (G8[g] > gs1 || (G8[g] == gs1 && g < 2 * q + 1)) ? 1 : 0; }
            const bool sel0 = rk0 < 4, sel1 = rk1 < 4;
#pragma unroll
            for (int i = 0; i < 8; ++i) { mb[i] = sel0 ? mb[i] : -INFINITY; mb[8 + i] = sel1 ? mb[8 + i] : -INFINITY; }
            int eidx[8]; float esc[8]; float ssum = 0.f;
#pragma unroll
            for (int k = 0; k < TOPK; ++k) {
                float lm = mb[0]; int li = 0;
#pragma unroll
                for (int i = 1; i < 16; ++i) { const bool gt = mb[i] > lm; lm = gt ? mb[i] : lm; li = gt ? i : li; }
                float m = fmaxf(lm, dppf<DPP_XOR1>(lm)); m = fmaxf(m, dppf<DPP_XOR2>(m));
                int cand = (lm == m) ? 16 * q + li : 9999;
                int widx = min(cand, dppi<DPP_XOR1>(cand)); widx = min(widx, dppi<DPP_XOR2>(widx));
                const bool mine = (cand == widx); float sv = 0.f;
#pragma unroll
                for (int i = 0; i < 16; ++i) { const bool hit = mine && (i == li); sv = hit ? sc[i] : sv; mb[i] = hit ? -INFINITY : mb[i]; }
                sv += dppf<DPP_XOR1>(sv); sv += dppf<DPP_XOR2>(sv);
                eidx[k] = widx; esc[k] = sv; ssum += sv;
            }
            const float inv = ROUTE_SCALE / ssum;
            const int e0 = q == 0 ? eidx[0] : q == 1 ? eidx[2] : q == 2 ? eidx[4] : eidx[6], e1 = q == 0 ? eidx[1] : q == 1 ? eidx[3] : q == 2 ? eidx[5] : eidx[7];
            const float w0 = (q == 0 ? esc[0] : q == 1 ? esc[2] : q == 2 ? esc[4] : esc[6]) * inv, w1 = (q == 0 ? esc[1] : q == 1 ? esc[3] : q == 2 ? esc[5] : esc[7]) * inv;
            const int lr0 = __hip_atomic_fetch_add(&lcnt[e0], 1, __ATOMIC_RELAXED, __HIP_MEMORY_SCOPE_WORKGROUP), lr1 = __hip_atomic_fetch_add(&lcnt[e1], 1, __ATOMIC_RELAXED, __HIP_MEMORY_SCOPE_WORKGROUP);
            const size_t o = (size_t)t * 8 + 2 * q;
            *(GAS v2u*)(TOKE + o) = (v2u){(unsigned)e0, (unsigned)e1}; *(GAS f32x2*)(TOKW + o) = (f32x2){w0, w1}; *(GAS v2u*)(TOKLR + o) = (v2u){(unsigned)lr0, (unsigned)lr1};
        }
        __syncthreads();
        if (F.tid < 64) CNT[tile * 64 + F.tid] = lcnt[F.tid];
        __syncthreads();
    }
}

__device__ __forceinline__ void assign_phase(Frame& F) {
    const int* CNT = (const int*)(F.ws + TAB_CNT); int* TILEE = (int*)(F.ws + TAB_TILEE); int* META = (int*)(F.ws + TAB_META);
    const int* TOKE = (const int*)(F.ws + WS_TOKE); const float* TOKW = (const float*)(F.ws + WS_TOKW); const int* TOKLR = (const int*)(F.ws + WS_TOKLR);
    int* TOKSLOT = (int*)(F.ws + WS_TOKSLOT); int* ROWTOK = (int*)(F.ws + WS_ROWTOK); float* ROWW = (float*)(F.ws + WS_ROWW);
    LAS int* lpart = (LAS int*)(F.lds); LAS int* ltot = lpart + 512 * 2; LAS int* lbase = ltot + 64; LAS int* lseg = lbase + 64; LAS int* lnt = lseg + 64;
    bool first = true;
    for (int tile = F.vcu; tile < T / 128; tile += F.G) {
        { const int e = F.tid & 63, part = F.tid >> 6; int tot = 0, bs = 0;
#pragma unroll 8
          for (int tt = part * 32; tt < part * 32 + 32; ++tt) { const int c = CNT[tt * 64 + e]; tot += c; bs += (tt < tile) ? c : 0; }
          lpart[(part * 64 + e) * 2] = tot; lpart[(part * 64 + e) * 2 + 1] = bs; }
        __syncthreads();
        if (F.tid < 64) { int tot = 0, bs = 0;
#pragma unroll
            for (int part = 0; part < 8; ++part) { tot += lpart[(part * 64 + F.tid) * 2]; bs += lpart[(part * 64 + F.tid) * 2 + 1]; }
            ltot[F.tid] = tot; lbase[F.tid] = bs; }
        __syncthreads();
        if (F.tid == 0) { int run = 0;
            for (int e = 0; e < NE; ++e) { lseg[e] = run; run += (ltot[e] + 255) & ~255; }
            lnt[0] = run >> 8; }
        __syncthreads();
#pragma unroll
        for (int q = 0; q < 2; ++q) { const int idx = F.tid + q * 512; const size_t tk = (size_t)tile * 1024 + idx; const int e = TOKE[tk];
            const int slot = lseg[e] + lbase[e] + TOKLR[tk];
            TOKSLOT[tk] = slot; ROWTOK[slot] = (int)(tk >> 3); ROWW[slot] = TOKW[tk]; }
        if (first) {
            first = false;
            for (int p = F.vcu; p < NE; p += F.G) { const int seg = lseg[p], tot = ltot[p], pad = (tot + 255) & ~255;
                for (int r = seg + tot + F.tid; r < seg + pad; r += NWAVES * 64) { ROWTOK[r] = 0; ROWW[r] = 0.f; }
                for (int tl = (seg >> 8) + F.tid; tl < ((seg + pad) >> 8); tl += NWAVES * 64) TILEE[tl] = p;
                if (F.tid == 0) { META[MT_ESTART + p] = seg >> 8; META[MT_ECNT + p] = pad >> 8; } }
            if (F.vcu == 0 && F.tid == 0) META[MT_NT] = lnt[0];
            for (int i = F.vcu * (NWAVES * 64) + F.tid; i < T; i += F.G * NWAVES * 64) { ROWTOK[ROUTED_TILES * 256 + i] = i; ROWW[ROUTED_TILES * 256 + i] = 1.0f; }
        }
        __syncthreads();
    }
}

struct Moe1Order {
    const int* tile_e; int nt, G, c;
    __device__ __forceinline__ bool next(int i, pg8::Unit& u) const {
        const int nR = 2 * nt, nU = nR + 2 * SH_TILES; const long Lr = (long)i * G + c; if (Lr >= nU) return false;
        const int L = pg8::xcd_remap((int)Lr, nU);
        int rt, e; const int pn = L & 1;
        if (L < nR) { rt = L >> 1; e = tile_e[rt]; } else { rt = ROUTED_TILES + ((L - nR) >> 1); e = NE; }
        u.pm = rt; u.pn = pn; u.at = rt; u.bt = e * 2 + pn; return true;
    }
    __device__ __forceinline__ int row_tile(int i) const {
        const int nR = 2 * nt, nU = nR + 2 * SH_TILES; const long Lr = (long)i * G + c; if (Lr >= nU) return -1;
        const int L = pg8::xcd_remap((int)Lr, nU); return L < nR ? (L >> 1) : ROUTED_TILES + ((L - nR) >> 1);
    }
};
struct Moe2Order {
    const int* tile_e; int nt, G, c;
    __device__ __forceinline__ bool next(int i, pg8::Unit& u) const {
        const int nU = 4 * nt; const long Lr = (long)i * G + c; if (Lr >= nU) return false;
        const int L = pg8::xcd_remap((int)Lr, nU);
        const int rt = L >> 2, pn = L & 3, e = tile_e[rt];
        u.pm = rt; u.pn = pn; u.at = rt; u.bt = e * 4 + pn; return true;
    }
};

__device__ __forceinline__ void moe2_stationary_phase(Frame& F) {
    const int* META = (const int*)(F.ws + TAB_META);
    const unsigned char* H = F.ws + WS_H; const unsigned char* W2 = F.ws + WS_W2; unsigned char* Y = F.ws + WS_Y;
    int lx = F.lane; asm volatile("" : "+v"(lx));
    const int w = F.wave, fr = lx & 15, fq = lx >> 4, cg = w & 3, rg = w >> 2;
    int f8sa = 0x01010101 * (127 - 5), f8sb = 0x7f7f7f7f; asm volatile("" : "+v"(f8sa), "+v"(f8sb));
    const int aoff = pg8::lds_byte(rg * 64 + fr, fq * 8);
    unsigned voff[2];
#pragma unroll
    for (int i = 0; i < 2; ++i) { int R, C; pg8::stage_rc((w * 64 + lx) * 16 + i * 8192, R, C); voff[i] = (unsigned)(R * 256 + C * 2); }
    const unsigned ldsw = (unsigned)w * 1024u;
#define M2_STAGE(slot, rowbase) do { const unsigned char* g_ = H + (size_t)(rowbase) * 256; _Pragma("unroll") for (int kt_ = 0; kt_ < 2; ++kt_) _Pragma("unroll") for (int i_ = 0; i_ < 2; ++i_) \
        __builtin_amdgcn_global_load_lds((const unsigned*)(g_ + voff[i_] + kt_ * 128), (LAS unsigned*)(F.lds + RING_OFF + (slot) * 32768 + kt_ * 16384 + ldsw + i_ * 8192), 16, 0, 0); } while (0)
    for (int pair = F.vcu; pair < 4 * NE; pair += F.G) {
        const int e = pair >> 2, pn = pair & 3, t0 = META[MT_ESTART + e], ntl = META[MT_ECNT + e], nhp = 2 * ntl;
        if (nhp == 0) continue;
        pg8::i32x8 Bf[4][2];
#pragma unroll
        for (int nf = 0; nf < 4; ++nf)
#pragma unroll
            for (int kt = 0; kt < 2; ++kt) { const unsigned char* bp = W2 + ((size_t)e * D + pn * 256 + cg * 64 + 16 * (fr >> 2) + 4 * nf + (fr & 3)) * FF + kt * 128 + 16 * fq;
                const pg8::i32x4 lo = *(const GAS pg8::i32x4*)bp, hi = *(const GAS pg8::i32x4*)(bp + 64); Bf[nf][kt] = __builtin_shufflevector(lo, hi, 0, 1, 2, 3, 4, 5, 6, 7); }
        asm volatile("s_waitcnt vmcnt(0)" ::: "memory");
        __syncthreads();
        const int rb0 = t0 * 256;
        M2_STAGE(0, rb0); M2_STAGE(1, rb0 + (nhp > 1 ? 128 : 0));
        for (int p = 0; p < nhp; ++p) {
            if (p == 0) asm volatile("s_waitcnt vmcnt(4)" ::: "memory"); else if (p == 1) asm volatile("s_waitcnt vmcnt(8)" ::: "memory"); else asm volatile("s_waitcnt vmcnt(12)" ::: "memory");
            __builtin_amdgcn_s_barrier(); asm volatile("" ::: "memory");
            { const int pnx = (p + 2 < nhp) ? p + 2 : p; M2_STAGE((p + 2) % 3, rb0 + pnx * 128); }
            const int slot = p % 3; const unsigned sb = (unsigned)(RING_OFF + slot * 32768);
            pg8::f32x4 acc[4][4];
#pragma unroll
            for (int kt = 0; kt < 2; ++kt)
#pragma unroll
                for (int m = 0; m < 4; ++m) { pg8::i32x8 Af;
                    { const pg8::i32x4 lo = *(const LAS pg8::i32x4*)(F.lds + sb + kt * 16384 + aoff + m * 2048), hi = *(const LAS pg8::i32x4*)(F.lds + sb + kt * 16384 + aoff + m * 2048 + 1024); Af = __builtin_shufflevector(lo, hi, 0, 1, 2, 3, 4, 5, 6, 7); }
#pragma unroll
                    for (int nf = 0; nf < 4; ++nf) {
                        if (kt == 0) asm volatile("v_mfma_scale_f32_16x16x128_f8f6f4 %0, %1, %2, 0, %3, %4 op_sel_hi:[0,0,0]" : "=&v"(acc[m][nf]) : "v"(Bf[nf][kt]), "v"(Af), "v"(f8sa), "v"(f8sb));
                        else         asm volatile("v_mfma_scale_f32_16x16x128_f8f6f4 %0, %1, %2, %0, %3, %4 op_sel_hi:[0,0,0]" : "+v"(acc[m][nf]) : "v"(Bf[nf][kt]), "v"(Af), "v"(f8sa), "v"(f8sb)); } }
            asm volatile("s_nop 15\n\ts_nop 15" ::: "memory");
            LAS unsigned char* stg = F.lds + RING_OFF + 3 * 32768;
#pragma unroll
            for (int m = 0; m < 4; ++m) { v4u o;
                o.x = pg8::pk4_fp8(acc[m][0][0], acc[m][0][1], acc[m][0][2], acc[m][0][3]); o.y = pg8::pk4_fp8(acc[m][1][0], acc[m][1][1], acc[m][1][2], acc[m][1][3]);
                o.z = pg8::pk4_fp8(acc[m][2][0], acc[m][2][1], acc[m][2][2], acc[m][2][3]); o.w = pg8::pk4_fp8(acc[m][3][0], acc[m][3][1], acc[m][3][2], acc[m][3][3]);
                *(LAS v4u*)(stg + (rg * 64 + 16 * m + fr) * 272 + cg * 64 + 16 * fq) = o; }
            asm volatile("s_waitcnt lgkmcnt(0)" ::: "memory"); __builtin_amdgcn_s_barrier(); asm volatile("" ::: "memory");
            { const size_t rowb = (size_t)rb0 + (size_t)p * 128 + 16 * w;
#pragma unroll
              for (int i = 0; i < 4; ++i) { const int rl = 4 * i + (lx >> 4); const v4u o = *(const LAS v4u*)(stg + (16 * w + rl) * 272 + 16 * (lx & 15));
                  __builtin_nontemporal_store(o, (GAS v4u*)(Y + (rowb + rl) * D + pn * 256 + 16 * (lx & 15))); } }
        }
        asm volatile("s_waitcnt vmcnt(0)" ::: "memory");
        __syncthreads();
    }
#undef M2_STAGE
}

__device__ __forceinline__ void combine_phase(Frame& F) {
    const unsigned char* Y = (const unsigned char*)(F.ws + WS_Y); const int* TOKSLOT = (const int*)(F.ws + WS_TOKSLOT);
    const int gw = F.vcu * NWAVES + F.wave, NGW = F.G * NWAVES;
    f32x4 g4[4], b4[4];
#pragma unroll
    for (int j = 0; j < 4; ++j) { g4[j] = *(const GAS f32x4*)(F.ln2_g + 256 * j + 4 * F.lane); b4[j] = *(const GAS f32x4*)(F.ln2_b + 256 * j + 4 * F.lane); }
#pragma unroll 4
    for (int m = gw; m < T; m += NGW) {
        GAS f32x4* xr = (GAS f32x4*)(F.out + (size_t)m * D) + F.lane;
        unsigned yw[TOPK][4];
#pragma unroll
        for (int k = 0; k < TOPK; ++k) { const int slot = TOKSLOT[(size_t)m * 8 + k]; const GAS unsigned* yr = (const GAS unsigned*)(Y + (size_t)slot * D) + F.lane;
#pragma unroll
            for (int j = 0; j < 4; ++j) yw[k][j] = NTL(yr + 64 * j); }
        f32x4 v[4];
#pragma unroll
        for (int j = 0; j < 4; ++j) { const v2u pw = NTL((const GAS v2u*)((const GAS unsigned char*)(F.out + (size_t)m * D) + 512 * j + 8 * F.lane)); v[j] = (f32x4){blo(pw.x), bhi(pw.x), blo(pw.y), bhi(pw.y)}; }
        f32x4 a[4];
#pragma unroll
        for (int j = 0; j < 4; ++j) a[j] = (f32x4){0.f, 0.f, 0.f, 0.f};
#pragma unroll
        for (int k = 0; k < TOPK; ++k)
#pragma unroll
            for (int j = 0; j < 4; ++j) { const f32x2 lo = __builtin_amdgcn_cvt_pk_f32_fp8((int)yw[k][j], false), hi = __builtin_amdgcn_cvt_pk_f32_fp8((int)yw[k][j], true);
                a[j].x += lo.x; a[j].y += lo.y; a[j].z += hi.x; a[j].w += hi.y; }
        float s = 0.f;
#pragma unroll
        for (int j = 0; j < 4; ++j) { v[j] = v[j] + a[j] * (1.0f / Y_SCALE); s += (v[j].x + v[j].y) + (v[j].z + v[j].w); }
        const float mean = wave_sum(s) * (1.f / D); float s2 = 0.f;
#pragma unroll
        for (int j = 0; j < 4; ++j) { v[j] = v[j] - mean; s2 += (v[j].x * v[j].x + v[j].y * v[j].y) + (v[j].z * v[j].z + v[j].w * v[j].w); }
        const float rstd = 1.f / sqrtf(wave_sum(s2) * (1.f / D) + LN_EPS);
#pragma unroll
        for (int j = 0; j < 4; ++j) xr[64 * j] = v[j] * rstd * g4[j] + b4[j];
    }
}
typedef float f32x16 __attribute__((ext_vector_type(16)));
typedef short s16x8 __attribute__((ext_vector_type(8)));
typedef short s16x4 __attribute__((ext_vector_type(4)));
constexpr int GQ_P = 272, GV_P = 144;
constexpr int G_QT = 0, G_KT = G_QT + 64 * GQ_P, G_KD = G_KT + 64 * GQ_P, G_VT = G_KD + 128 * GV_P, G_AM = G_VT + 256 * GV_P, G_SEG = G_AM + 64 * GV_P,
              G_DL = G_SEG + 8 * 128 * 4, G_WG = G_DL + 512, G_BG = G_WG + 128 * 16 * 4, G_GL = G_BG + 512, G_END = G_GL + 64 * 16 * 4, G_OB = G_QT, G_OBP = 260;
static_assert(G_END <= LDSCTL_OFF && 32 * G_OBP * 4 <= 2 * 64 * GQ_P, "GLA LDS map");
constexpr size_t TAB_DG = WS_TAB + 131072;

template <int MODE>
__device__ __forceinline__ void gla_units(Frame& F) {
    const bf16* QK = (const bf16*)(F.ws + WS_QK); const bf16* VB = (const bf16*)(F.ws + WS_V); const bf16* RB = (const bf16*)(F.ws + WS_R); bf16* OG = (bf16*)(F.ws + WS_OG);
    const float* GLR = (const float*)(F.ws + WS_GLR); float* LS = (float*)(F.ws + WS_L); float* DG = (float*)(F.ws + TAB_DG);
    LAS unsigned char* L = F.lds; bf16* GLG = (bf16*)F.out;
    const int lane = F.lane, w = F.wave, ig = w;
    const f32x4 gn = *(const GAS f32x4*)(F.gla_norm_g + 4 * lane);
#define GLA_LANE() int lx_ = lane; asm volatile("" : "+v"(lx_)); const int hh = lx_ >> 5, ln = lx_ & 31, d0 = 2 * lx_; (void)hh; (void)ln; (void)d0
    for (int u = F.vcu; u < 256; u += F.G) {
        const int b = u >> 7, h = (u >> 5) & 3, grp = u & 31; const size_t tok0 = (size_t)b * SEQ + (size_t)grp * 512;
        __syncthreads();
        if (MODE == 0 && F.tid < 128) { const int d = F.tid;
#pragma unroll
            for (int r = 0; r < GRANK; ++r) *(LAS float*)(L + G_WG + (r * 128 + d) * 4) = F.w_gate_up[r * 512 + h * 128 + d];
            *(LAS float*)(L + G_BG + d * 4) = F.b_gate[h * 128 + d]; }
        f32x16 S[4];
        if (MODE == 0) {
#pragma unroll
            for (int t = 0; t < 4; ++t)
#pragma unroll
                for (int r = 0; r < 16; ++r) S[t][r] = 0.f;
        } else {
#pragma unroll
            for (int t = 0; t < 4; ++t)
#pragma unroll
                for (int rp = 0; rp < 8; ++rp) { const unsigned wd = ((const unsigned*)LS)[(size_t)u * 16384 + ((w * 4 + t) * 8 + rp) * 64 + lane]; S[t][2 * rp] = blo(wd); S[t][2 * rp + 1] = bhi(wd); }
        }
        f32x2 gsum = (f32x2){0.f, 0.f};
        unsigned qraw[8], kraw[8], vraw[2][8], graw[8]; f32x2 glq = (f32x2){0.f, 0.f}; v2u rraw[2][4];
#define GLA_LOADR(c) do { const size_t t0_ = tok0 + 64 * (c); GLA_LANE(); _Pragma("unroll") for (int rt_ = 0; rt_ < 2; ++rt_) _Pragma("unroll") for (int q_ = 0; q_ < 4; ++q_) \
            rraw[rt_][q_] = NTL((const GAS v2u*)(RB + (t0_ + 32 * rt_ + 4 * w + q_) * 1024 + h * 256 + 4 * lx_)); } while (0)
#define GLA_LOAD(c) do { const size_t t0_ = tok0 + 64 * (c); GLA_LANE(); const int tid_ = w * 64 + lx_; \
            _Pragma("unroll") for (int i = 0; i < 8; ++i) { const size_t tk = t0_ + 8 * ig + i; kraw[i] = NTL((const GAS unsigned*)(QK + tk * 1024 + 512 + h * 128 + d0)); \
                if (MODE == 1) { qraw[i] = NTL((const GAS unsigned*)(QK + tk * 1024 + h * 128 + d0)); graw[i] = NTL((const GAS unsigned*)(GLG + tk * 512 + h * 128 + d0)); } } \
            if (MODE == 0) glq = *(const GAS f32x2*)(GLR + t0_ * GRANK + 2 * tid_); \
            _Pragma("unroll") for (int q = 0; q < 2; ++q) { const int id = tid_ + 512 * q, dvp = id & 127, tg = id >> 7; \
                _Pragma("unroll") for (int i = 0; i < 8; ++i) vraw[q][i] = NTL((const GAS unsigned*)(VB + (t0_ + 8 * tg + i) * 1024 + h * 256 + 2 * dvp)); } } while (0)
        GLA_LOAD(0);
        if (MODE == 1) GLA_LOADR(0);
        if (MODE == 0) *(LAS f32x2*)(L + G_GL + F.tid * 8) = glq;
        __syncthreads();
        for (int c = 0; c < 8; ++c) {
            const size_t t0 = tok0 + 64 * c;
            f32x2 cs[8];
            {
                GLA_LANE();
                f32x2 run = (f32x2){0.f, 0.f};
                if (MODE == 0) {
                    f32x2 wg[GRANK];
#pragma unroll
                    for (int r = 0; r < GRANK; ++r) wg[r] = *(const LAS f32x2*)(L + G_WG + (r * 128 + d0) * 4);
                    const f32x2 bgv = *(const LAS f32x2*)(L + G_BG + d0 * 4);
#pragma unroll
                    for (int i = 0; i < 8; ++i) {
                        f32x2 z = bgv;
#pragma unroll
                        for (int q = 0; q < 4; ++q) { const f32x4 g4 = *(const LAS f32x4*)(L + G_GL + ((8 * ig + i) * 16 + 4 * q) * 4);
                            z += wg[4 * q] * g4.x; z += wg[4 * q + 1] * g4.y; z += wg[4 * q + 2] * g4.z; z += wg[4 * q + 3] * g4.w; }
                        const float l0 = (fminf(z.x, 0.f) - __logf(1.0f + __expf(-fabsf(z.x)))) * (1.0f / 16.0f), l1 = (fminf(z.y, 0.f) - __logf(1.0f + __expf(-fabsf(z.y)))) * (1.0f / 16.0f);
                        const unsigned gp = cvtpk(l0, l1);
                        *(GAS unsigned*)(GLG + (t0 + 8 * ig + i) * 512 + h * 128 + d0) = gp;
                        run += (f32x2){blo(gp), bhi(gp)}; cs[i] = run;
                    }
                } else {
#pragma unroll
                    for (int i = 0; i < 8; ++i) { run += (f32x2){blo(graw[i]), bhi(graw[i])}; cs[i] = run; }
                }
                *(LAS f32x2*)(L + G_SEG + (ig * 128 + d0) * 4) = run;
            }
            { GLA_LANE(); const int tid_ = w * 64 + lx_;
#pragma unroll
            for (int q = 0; q < 2; ++q) { const int id = tid_ + 512 * q, dvp = id & 127, tg = id >> 7;
                v4u lo, hi;
                lo.x = (vraw[q][0] & 0xffffu) | (vraw[q][1] << 16); lo.y = (vraw[q][2] & 0xffffu) | (vraw[q][3] << 16); lo.z = (vraw[q][4] & 0xffffu) | (vraw[q][5] << 16); lo.w = (vraw[q][6] & 0xffffu) | (vraw[q][7] << 16);
                hi.x = (vraw[q][0] >> 16) | (vraw[q][1] & 0xffff0000u); hi.y = (vraw[q][2] >> 16) | (vraw[q][3] & 0xffff0000u); hi.z = (vraw[q][4] >> 16) | (vraw[q][5] & 0xffff0000u); hi.w = (vraw[q][6] >> 16) | (vraw[q][7] & 0xffff0000u);
                *(LAS v4u*)(L + G_VT + (2 * dvp) * GV_P + tg * 16) = lo; *(LAS v4u*)(L + G_VT + (2 * dvp + 1) * GV_P + tg * 16) = hi; } }
            LDS_BARRIER();
            {
                GLA_LANE();
                f32x2 pre = (f32x2){0.f, 0.f}, tot = (f32x2){0.f, 0.f};
#pragma unroll
                for (int s = 0; s < 8; ++s) { const f32x2 sv = *(const LAS f32x2*)(L + G_SEG + (s * 128 + d0) * 4); tot += sv; if (s < ig) pre += sv; }
                const f32x2 dl = (f32x2){__expf(tot.x), __expf(tot.y)};
                if (ig == 0) *(LAS f32x2*)(L + G_DL + d0 * 4) = dl;
                gsum += tot;
                f32x2 kd[8];
#pragma unroll
                for (int i = 0; i < 8; ++i) {
                    const f32x2 bb = pre + cs[i];
                    const f32x2 kk = (f32x2){blo(kraw[i]), bhi(kraw[i])};
                    if (MODE == 1) {
                        const f32x2 kt = kk * (f32x2){__expf(-bb.x), __expf(-bb.y)};
                        const f32x2 qq = (f32x2){blo(qraw[i]), bhi(qraw[i])} * (f32x2){__expf(bb.x), __expf(bb.y)};
                        *(LAS unsigned*)(L + G_QT + (8 * ig + i) * GQ_P + d0 * 2) = cvtpk(qq.x, qq.y);
                        *(LAS unsigned*)(L + G_KT + (8 * ig + i) * GQ_P + d0 * 2) = cvtpk(kt.x, kt.y);
                        kd[i] = kt * dl;
                    } else { kd[i] = kk * (f32x2){__expf(tot.x - bb.x), __expf(tot.y - bb.y)}; }
                }
                v4u p0, p1;
                p0.x = cvtpk(kd[0].x, kd[1].x); p0.y = cvtpk(kd[2].x, kd[3].x); p0.z = cvtpk(kd[4].x, kd[5].x); p0.w = cvtpk(kd[6].x, kd[7].x);
                p1.x = cvtpk(kd[0].y, kd[1].y); p1.y = cvtpk(kd[2].y, kd[3].y); p1.z = cvtpk(kd[4].y, kd[5].y); p1.w = cvtpk(kd[6].y, kd[7].y);
                *(LAS v4u*)(L + G_KD + d0 * GV_P + ig * 16) = p0; *(LAS v4u*)(L + G_KD + (d0 + 1) * GV_P + ig * 16) = p1;
            }
            if (c < 7) GLA_LOAD(c + 1);
            LDS_BARRIER();
            f32x16 o[2];
            if (MODE == 1) {
                GLA_LANE();
#pragma unroll
                for (int tt = 0; tt < 2; ++tt) { const int id = 2 * w + tt, ti = id >> 2, tj = id & 3, r16 = lx_ & 15, kg = lx_ >> 4;
                    f32x4 sc = (f32x4){0.f, 0.f, 0.f, 0.f};
#pragma unroll
                    for (int ks = 0; ks < 4; ++ks) { const s16x8 ka = *(const LAS s16x8*)(L + G_KT + (16 * tj + r16) * GQ_P + (32 * ks + 8 * kg) * 2), qb = *(const LAS s16x8*)(L + G_QT + (16 * ti + r16) * GQ_P + (32 * ks + 8 * kg) * 2);
                        sc = __builtin_amdgcn_mfma_f32_16x16x32_bf16(ka, qb, sc, 0, 0, 0); }
                    const int i = 16 * ti + r16, j0 = 16 * tj + 4 * kg;
                    v2u pw; pw.x = cvtpk(j0 <= i ? sc[0] : 0.f, j0 + 1 <= i ? sc[1] : 0.f); pw.y = cvtpk(j0 + 2 <= i ? sc[2] : 0.f, j0 + 3 <= i ? sc[3] : 0.f);
                    *(LAS v2u*)(L + G_AM + i * GV_P + j0 * 2) = pw; }
                __builtin_amdgcn_sched_barrier(0);
#pragma unroll
                for (int rt = 0; rt < 2; ++rt)
#pragma unroll
                    for (int r = 0; r < 16; ++r) o[rt][r] = 0.f;
#pragma unroll
                for (int t = 0; t < 4; ++t)
#pragma unroll
                    for (int s = 0; s < 2; ++s) {
                        v4u pb; pb.x = cvtpk(S[t][8 * s], S[t][8 * s + 1]); pb.y = cvtpk(S[t][8 * s + 2], S[t][8 * s + 3]); pb.z = cvtpk(S[t][8 * s + 4], S[t][8 * s + 5]); pb.w = cvtpk(S[t][8 * s + 6], S[t][8 * s + 7]);
                        const s16x8 bfrag = __builtin_bit_cast(s16x8, pb);
#pragma unroll
                        for (int rt = 0; rt < 2; ++rt) { const int dk = 32 * t + 16 * s + 4 * hh;
                            const v2u a0 = *(const LAS v2u*)(L + G_QT + (32 * rt + ln) * GQ_P + dk * 2), a1 = *(const LAS v2u*)(L + G_QT + (32 * rt + ln) * GQ_P + (dk + 8) * 2);
                            const v4u av = (v4u){a0.x, a0.y, a1.x, a1.y};
                            o[rt] = __builtin_amdgcn_mfma_f32_32x32x16_bf16(__builtin_bit_cast(s16x8, av), bfrag, o[rt], 0, 0, 0); }
                        __builtin_amdgcn_sched_barrier(0);
                    }
                LDS_BARRIER();
            }
            {
                GLA_LANE();
                s16x8 vf[4];
#pragma unroll
                for (int s = 0; s < 4; ++s) vf[s] = *(const LAS s16x8*)(L + G_VT + (32 * w + ln) * GV_P + (16 * s + 8 * hh) * 2);
                if (MODE == 1) {
#pragma unroll
                    for (int s = 0; s < 4; ++s)
#pragma unroll
                        for (int rt = 0; rt < 2; ++rt) { if (rt == 0 && s >= 2) continue;
                            const s16x8 af = *(const LAS s16x8*)(L + G_AM + (32 * rt + ln) * GV_P + (16 * s + 8 * hh) * 2);
                            o[rt] = __builtin_amdgcn_mfma_f32_32x32x16_bf16(af, vf[s], o[rt], 0, 0, 0); }
                }
#pragma unroll
                for (int t = 0; t < 4; ++t) {
#pragma unroll
                    for (int g = 0; g < 4; ++g) { const f32x4 dv4 = *(const LAS f32x4*)(L + G_DL + (32 * t + 8 * g + 4 * hh) * 4);
                        S[t][4 * g] *= dv4.x; S[t][4 * g + 1] *= dv4.y; S[t][4 * g + 2] *= dv4.z; S[t][4 * g + 3] *= dv4.w; }
#pragma unroll
                    for (int s = 0; s < 4; ++s) { const s16x8 af = *(const LAS s16x8*)(L + G_KD + (32 * t + ln) * GV_P + (16 * s + 8 * hh) * 2);
                        S[t] = __builtin_amdgcn_mfma_f32_32x32x16_bf16(af, vf[s], S[t], 0, 0, 0); }
                    __builtin_amdgcn_sched_barrier(0);
                }
            }
            if (MODE == 0) { if (c < 7) *(LAS f32x2*)(L + G_GL + F.tid * 8) = glq; LDS_BARRIER(); }
            else {
#pragma unroll
                for (int rt = 0; rt < 2; ++rt) {
                    GLA_LANE();
                    if (rt == 1) LDS_BARRIER();
#pragma unroll
                    for (int r = 0; r < 16; ++r) *(LAS float*)(L + G_OB + (((r & 3) + 8 * (r >> 2) + 4 * hh) * G_OBP + 32 * w + ln) * 4) = o[rt][r];
                    LDS_BARRIER();
#pragma unroll
                    for (int q = 0; q < 4; ++q) { const int tl = 4 * w + q;
                        const f32x4 ov = *(const LAS f32x4*)(L + G_OB + (tl * G_OBP + 4 * lx_) * 4);
                        const float ss = wave_sum(ov.x * ov.x + ov.y * ov.y + ov.z * ov.z + ov.w * ov.w), rinv = __builtin_amdgcn_rsqf(ss * (1.0f / 256.0f) + RMS_EPS);
                        const float r0 = blo(rraw[rt][q].x), r1 = bhi(rraw[rt][q].x), r2 = blo(rraw[rt][q].y), r3 = bhi(rraw[rt][q].y);
                        v2u ow; ow.x = cvtpk(ov.x * rinv * gn.x * (r0 * pg8::sigm(r0)), ov.y * rinv * gn.y * (r1 * pg8::sigm(r1))); ow.y = cvtpk(ov.z * rinv * gn.z * (r2 * pg8::sigm(r2)), ov.w * rinv * gn.w * (r3 * pg8::sigm(r3)));
                        *(GAS v2u*)(OG + (t0 + 32 * rt + tl) * 1024 + h * 256 + 4 * lx_) = ow; }
                }
                if (c < 7) GLA_LOADR(c + 1);
            }
        }
#undef GLA_LOAD
#undef GLA_LOADR
        if (MODE == 0) {
#pragma unroll
            for (int t = 0; t < 4; ++t)
#pragma unroll
                for (int rp = 0; rp < 8; ++rp) ((unsigned*)LS)[(size_t)u * 16384 + ((w * 4 + t) * 8 + rp) * 64 + lane] = cvtpk(S[t][2 * rp], S[t][2 * rp + 1]);
            if (ig == 0) *(GAS f32x2*)(DG + (size_t)u * 128 + 2 * lane) = (f32x2){__expf(gsum.x), __expf(gsum.y)};
        }
    }
}
#undef GLA_LANE
__device__ __forceinline__ void gla_scan_phase(Frame& F) {
    unsigned* LSW = (unsigned*)(F.ws + WS_L); const float* DG = (const float*)(F.ws + TAB_DG);
    const int gt = F.vcu * (NWAVES * 64) + F.tid, NT = F.G * NWAVES * 64;
    for (int idx = gt; idx < 8 * 16384; idx += NT) {
        const int bh = idx >> 14, e = idx & 16383, l = e & 63, rp = (e >> 6) & 7, t = (e >> 9) & 3, r0 = 2 * rp, dk = 32 * t + (r0 & 3) + 8 * (r0 >> 2) + 4 * (l >> 5);
        float s0 = 0.f, s1 = 0.f;
#pragma unroll 8
        for (int j = 0; j < 32; ++j) { const size_t a = (size_t)(bh * 32 + j) * 16384 + e; const unsigned lv = LSW[a]; LSW[a] = cvtpk(s0, s1);
            const f32x2 dg = *(const f32x2*)(DG + (bh * 32 + j) * 128 + dk); s0 = dg.x * s0 + blo(lv); s1 = dg.y * s1 + bhi(lv); }
    }
}
constexpr int NPH = 12;
struct Args { const float* in[22]; float* out; unsigned char* ws; int ph_lo, ph_hi, li, pad; };
__global__ void __launch_bounds__(NWAVES * 64, 2) fwd(Args args) {
    extern __shared__ __attribute__((aligned(16))) unsigned char lds[];
    Frame F;
    F.lds = (LAS unsigned char*)lds;
    F.MISC = (volatile LAS unsigned*)(F.lds + MISC_OFF);
    F.tid = threadIdx.x; F.lane = F.tid & 63; F.wave = __builtin_amdgcn_readfirstlane(F.tid >> 6);
    F.G = gridDim.x; { const int bx = blockIdx.x; F.vcu = (F.G % 8 == 0) ? (bx % 8) * (F.G / 8) + bx / 8 : bx; }
    F.ws = args.ws; F.ctl = (gu32*)(args.ws + WS_CTL); F.out = args.out;
    F.x = args.in[0]; F.w_in = args.in[1]; F.w_gate_up = args.in[2]; F.b_gate = args.in[3]; F.gla_norm_g = args.in[4]; F.w_gla_up = args.in[5]; F.w_pool_grp = args.in[6];
    F.pool_scale = args.in[7]; F.w_pool_up = args.in[8]; F.w_out = args.in[9]; F.ln1_g = args.in[10]; F.ln1_b = args.in[11]; F.w_router = args.in[12]; F.router_bias = args.in[13];
    F.w_exp_gate = args.in[14]; F.w_exp_up = args.in[15]; F.w_exp_down = args.in[16]; F.w_sh_gate = args.in[17]; F.w_sh_up = args.in[18]; F.w_sh_down = args.in[19]; F.ln2_g = args.in[20]; F.ln2_b = args.in[21];
    for (int u = F.tid; u < (LDS_BYTES - LDSCTL_OFF) / 4; u += NWAVES * 64) ((LAS unsigned*)(F.lds + LDSCTL_OFF))[u] = 0u;
    __syncthreads();
    XcdBarrier bar; bar.bar = (unsigned*)(F.ctl + CW_BAR); bar.x = 0; bar.st = nullptr;
    if (MK_FUSED) bar = xcd_barrier_post((unsigned*)(F.ctl + CW_BAR), F.MISC + 8);
#define GRID_BAR() do { if (MK_FUSED) xcd_barrier(bar); } while (0)
    const int lo = args.ph_lo, hi = args.ph_hi;
#ifdef PHASE_ONLY
#define IN(k) ((k) == PHASE_ONLY && lo <= (k) && (k) < hi)
#else
#define IN(k) (lo <= (k) && (k) < hi)
#endif
#define BOTH(k) (IN(k) && IN((k) + 1))
    const PG8_LAS int* idxtab = (const PG8_LAS int*)(F.lds + IDX_OFF);
    bf16* const QK = (bf16*)(F.ws + WS_QK); bf16* const VB = (bf16*)(F.ws + WS_V); bf16* const RB = (bf16*)(F.ws + WS_R); bf16* const UB = (bf16*)(F.ws + WS_U);
    bf16* const GA = (bf16*)(F.ws + WS_GA); bf16* const GB = (bf16*)(F.ws + WS_GB);

    if (IN(0)) { p0_prologue(F); if (BOTH(0)) GRID_BAR(); }
    if (IN(1)) { {
        pg8::StaticOrder S; S.init(T, NPROJ, F.G, (int)blockIdx.x);
        pg8::EpiProj E{QK, VB, RB, UB, GA, GB};
        pg8::gemm_phase<pg8::EpiProj, pg8::StaticOrder, PG8_ALIGN, PG8_SP2, false>(F.lds + RING_OFF, (const bf16*)(F.ws + WS_XB), (const bf16*)(F.ws + WS_WIN), D, S, E, idxtab); }
        if (BOTH(1)) GRID_BAR();
    }
    if (IN(2)) { pool_phase(F); gla_units<0>(F); if (BOTH(2)) GRID_BAR(); }
    if (IN(3)) { gla_scan_phase(F); if (BOTH(3)) GRID_BAR(); }
    if (IN(4)) { gla_units<1>(F); if (BOTH(4)) GRID_BAR(); }
    if (IN(5)) { {
        pg8::StaticOrder S; S.init(T, D, F.G, (int)blockIdx.x);
        { pg8::EpiGate<0> E{GA, nullptr, (bf16*)(F.ws + WS_T1)};
          pg8::gemm_phase<pg8::EpiGate<0>, pg8::StaticOrder, PG8_ALIGN, PG8_SP2, false>(F.lds + RING_OFF, (const bf16*)(F.ws + WS_OG), (const bf16*)(F.ws + WS_WGLA), D, S, E, idxtab); }
        { pg8::EpiGate<1> E{GB, (const bf16*)(F.ws + WS_T1), (bf16*)(F.ws + WS_MG)};
          pg8::gemm_phase<pg8::EpiGate<1>, pg8::StaticOrder, PG8_ALIGN, PG8_SP2, false>(F.lds + RING_OFF, (const bf16*)(F.ws + WS_PO), (const bf16*)(F.ws + WS_WPC), PW, S, E, idxtab); } }
        if (BOTH(5)) GRID_BAR();
    }
    if (IN(6)) { {
        pg8::StaticOrder S; S.init(T, D, F.G, (int)blockIdx.x);
        pg8::EpiPre1 E{F.x, (bf16*)F.out, DN_ALPHA, (float*)(F.ws + WS_PST)};
        pg8::gemm_phase<pg8::EpiPre1, pg8::StaticOrder, PG8_ALIGN, PG8_SP2, false>(F.lds + RING_OFF, (const bf16*)(F.ws + WS_MG), (const bf16*)(F.ws + WS_WOUT), D, S, E, idxtab); }
        if (BOTH(6)) GRID_BAR();
    }
    if (IN(7)) { router_phase(F); expert_w1_phase(F); if (BOTH(7)) GRID_BAR(); }
    if (IN(8)) { assign_phase(F); if (BOTH(8)) GRID_BAR(); }
    const int* TILEE = (const int*)(F.ws + TAB_TILEE); const int* META = (const int*)(F.ws + TAB_META);
    if (IN(9)) { {
        Moe1Order S{TILEE, META[MT_NT], F.G, (int)blockIdx.x};
        { const int* ROWTOK = (const int*)(F.ws + WS_ROWTOK); LAS int* it = (LAS int*)(F.lds + IDX_OFF);
          int rowv[IDX_UNITS];
#pragma unroll
          for (int i = 0; i < IDX_UNITS; ++i) { const int rt = S.row_tile(i); rowv[i] = (rt >= 0 && F.tid < 256) ? ROWTOK[rt * 256 + F.tid] : 0; }
#pragma unroll
          for (int i = 0; i < IDX_UNITS; ++i) if (F.tid < 256) it[i * 256 + F.tid] = rowv[i];
          __syncthreads(); }
        pg8::EpiMoe1F8 E{F.ws + WS_H, (const float*)(F.ws + WS_ROWW)};
        pg8::gemm_phase<pg8::EpiMoe1F8, Moe1Order, PG8_ALIGN, PG8_SP2, true, true, -5>(F.lds + RING_OFF, (const bf16*)(F.ws + WS_H1F), (const bf16*)(F.ws + WS_W1), D / 2, S, E, idxtab); }
        expert_w2_phase(F);
        if (BOTH(9)) GRID_BAR();
    }
    if (IN(10)) {
        { pg8::StaticOrder S; S.init(T, D, F.G, (int)blockIdx.x);
          pg8::EpiPre2 E{(bf16*)F.out, (const float*)(F.ws + TAB_STATS), F.ln1_g, F.ln1_b, DN_ALPHA, 1.0f};
          pg8::gemm_phase<pg8::EpiPre2, pg8::StaticOrder, PG8_ALIGN, PG8_SP2, false, true, -9>(F.lds + RING_OFF, (const bf16*)(F.ws + WS_H + (size_t)ROUTED_TILES * 256 * FF), (const bf16*)(F.ws + WS_W2 + (size_t)NE * D * FF), FF / 2, S, E, idxtab); }
#ifdef MOE2_PG8
        { Moe2Order S{TILEE, META[MT_NT], F.G, (int)blockIdx.x};
          pg8::EpiFp8 E{(unsigned char*)(F.ws + WS_Y), D, 1.0f};
          pg8::gemm_phase<pg8::EpiFp8, Moe2Order, PG8_ALIGN, PG8_SP2, false, true, -5>(F.lds + RING_OFF, (const bf16*)(F.ws + WS_H), (const bf16*)(F.ws + WS_W2), FF / 2, S, E, idxtab); }
#else
        moe2_stationary_phase(F);
#endif
        if (BOTH(10)) GRID_BAR();
    }
    if (IN(11)) { combine_phase(F); }
#undef IN
#undef BOTH
}

extern "C" void kernel_launch(void* const* d_in, const int* in_sizes, int n_in, void* d_out, int out_size, void* d_ws, size_t ws_size, hipStream_t stream) {
    static int grid = 0;
    if (grid == 0) {
        if (n_in != 22 || in_sizes[0] != T * D || out_size != T * D || ws_size < WS_END) { fprintf(stderr, "kernel_launch: built for 22 inputs, x/out of %d floats, >= %zu bytes of workspace; got n_in %d, in0 %d, out %d, ws %zu; nothing launched\n", T * D, (size_t)WS_END, n_in, n_in > 0 ? in_sizes[0] : -1, out_size, ws_size); grid = -1; return; }
        int dev = 0, cus = 0, per_cu = 0;
        if (hipGetDevice(&dev) != hipSuccess || hipDeviceGetAttribute(&cus, hipDeviceAttributeMultiprocessorCount, dev) != hipSuccess) { fprintf(stderr, "kernel_launch: device query failed\n"); grid = -1; return; }
        if (hipFuncSetAttribute((const void*)fwd, hipFuncAttributeMaxDynamicSharedMemorySize, LDS_BYTES) != hipSuccess) { fprintf(stderr, "kernel_launch: hipFuncSetAttribute failed\n"); grid = -1; return; }
        if (hipOccupancyMaxActiveBlocksPerMultiprocessor(&per_cu, (const void*)fwd, NWAVES * 64, LDS_BYTES) != hipSuccess || per_cu < 1)
            fprintf(stderr, "kernel_launch: note: occupancy query reports %d workgroups per CU\n", per_cu);
        (void)hipGetLastError();
        grid = cus;
        if (grid > 256) grid = 256;
    }
    if (grid < 0) return;
    if (hipMemsetAsync((char*)d_ws + WS_CTL, 0, CTL_ZERO_BYTES, stream) != hipSuccess) { fprintf(stderr, "kernel_launch: memset failed\n"); return; }
    Args a{};
    for (int i = 0; i < 22; ++i) a.in[i] = (const float*)d_in[i];
    a.out = (float*)d_out; a.ws = (unsigned char*)d_ws;
#if MK_FUSED
    a.ph_lo = 0; a.ph_hi = NPH; a.li = 0;
    hipLaunchKernelGGL(fwd, dim3(grid), dim3(NWAVES * 64), LDS_BYTES, stream, a);
#else
    for (int li = 0; li < NPH; ++li) { a.ph_lo = li; a.ph_hi = li + 1; a.li = li; hipLaunchKernelGGL(fwd, dim3(grid), dim3(NWAVES * 64), LDS_BYTES, stream, a); }
#endif
    const hipError_t le = hipPeekAtLastError();
    if (le != hipSuccess) fprintf(stderr, "kernel_launch: launch failed: %s\n", hipGetErrorName(le));
}
```
